# Optimizing an MI355X kernel written in HIP

```python
import math
import jax, jax.numpy as jnp
from jax import lax
import numpy as np

D_MODEL = 1024
BATCH = 16
SEQ = 2048
DEPTH = 1
DEC_BATCH = 8
DEC_SEQ = 8192
PAST_LEN = 128

MIX_WIDTH = D_MODEL
HY_WIDTH = MIX_WIDTH // 2
ATT_WIDTH = MIX_WIDTH - HY_WIDTH
HEAD_DIM = 64
N_HEADS = ATT_WIDTH // HEAD_DIM
N_KV_HEADS = 2
GROUP = N_HEADS // N_KV_HEADS
HY_COLS = 3 * HY_WIDTH
Q_COLS = N_HEADS * HEAD_DIM
KV_COLS = N_KV_HEADS * HEAD_DIM
IN_COLS = HY_COLS + Q_COLS + 2 * KV_COLS
SHORT_CONV = 3
FILTER_EMB = 33
FILTER_BANDS = (FILTER_EMB - 1) // 2
FILTER_HIDDEN = 64
N_DIRS = 2
DECAY_TARGET = 1e-2
FAST_DECAY_PCT = 0.3
SLOW_DECAY_PCT = 1.5
GRID_W = 64
ROPE_THETA = 10000.0
AXIS_DIM = HEAD_DIM // 2
Q_BLOCK = 128
D_FF = ((8 * D_MODEL + 3 * 256 - 1) // (3 * 256)) * 256
EPS = 1e-6

kernel_name = 'hymba_hyena_gqa_axial_encoder'


def _rmsnorm(x, g):
    x32 = x.astype(jnp.float32)
    y = x32 * lax.rsqrt(jnp.mean(x32 * x32, axis=-1, keepdims=True) + EPS)
    return (y * g.astype(jnp.float32)).astype(x.dtype)


def _hyena_filter(L, w1, b1, w2, b2, w3, freq, decay):
    f32 = jnp.float32
    t = jnp.linspace(0.0, 1.0, L, dtype=f32)[:, None]
    w = (2.0 * math.pi / L) * jnp.arange(L, dtype=f32)
    bands = jnp.linspace(1e-4, FILTER_BANDS - 1, FILTER_BANDS, dtype=f32)
    ang = w[:, None] * bands[None, :]
    z = jnp.concatenate([t, jnp.cos(ang), -jnp.sin(ang)], axis=-1)
    fr = freq.astype(f32)
    h = jnp.sin(fr * (z @ w1.astype(f32) + b1.astype(f32)))
    h = jnp.sin(fr * (h @ w2.astype(f32) + b2.astype(f32)))
    h = (h @ w3.astype(f32)).reshape(L, N_DIRS, HY_WIDTH)
    h = h * jnp.exp(-t[:, :, None] * jnp.abs(decay.astype(f32))[None])
    h_fwd, h_bwd = h[:, 0], h[:, 1]
    k = jnp.concatenate([h_fwd, jnp.zeros((1, HY_WIDTH), f32), h_bwd[:0:-1]], axis=0)
    return k / jnp.sum(jnp.abs(k), axis=0, keepdims=True)


def _hyena(u, conv_w, conv_b, filt, d_bias):
    L = u.shape[1]
    pad = SHORT_CONV // 2
    up = jnp.pad(u, ((0, 0), (pad, pad), (0, 0)))
    uc = conv_b + sum(up[:, j:j + L] * conv_w[j] for j in range(SHORT_CONV))
    x0, x1, v = jnp.split(uc, 3, axis=-1)
    z = (x1 * v).astype(jnp.float32)
    n = 2 * L
    zf = jnp.fft.rfft(z, n=n, axis=1)
    kf = jnp.fft.rfft(filt, n=n, axis=0)
    y = jnp.fft.irfft(zf * kf[None], n=n, axis=1)[:, :L]
    y = y + z * d_bias.astype(jnp.float32)
    return (x0.astype(jnp.float32) * y).astype(u.dtype)


def _axial_rope(L):
    f32 = jnp.float32
    rows = L // GRID_W
    row = jnp.repeat(jnp.arange(rows, dtype=f32), GRID_W)
    col = jnp.tile(jnp.arange(GRID_W, dtype=f32), rows)
    inv = ROPE_THETA ** (-jnp.arange(0, AXIS_DIM, 2, dtype=f32) / AXIS_DIM)
    ang = jnp.concatenate([row[:, None] * inv, col[:, None] * inv], axis=-1)
    return jnp.cos(ang), jnp.sin(ang)


def _apply_rope(x, cos, sin):
    xp = x.reshape(x.shape[:-1] + (HEAD_DIM // 2, 2))
    a, b = xp[..., 0], xp[..., 1]
    c = cos[None, :, None, :]
    s = sin[None, :, None, :]
    return jnp.stack([a * c - b * s, a * s + b * c], axis=-1).reshape(x.shape)


def _attention(q, k, v):
    B, L = q.shape[:2]
    nb = L // Q_BLOCK
    qb = q.reshape(B, nb, Q_BLOCK, N_KV_HEADS, GROUP, HEAD_DIM).transpose(1, 0, 2, 3, 4, 5)
    scale = HEAD_DIM ** -0.5

    def block(qi):
        s = jnp.einsum('bqkgd,bskd->bkgqs', qi, k, preferred_element_type=jnp.float32) * scale
        p = jax.nn.softmax(s, axis=-1).astype(v.dtype)
        return jnp.einsum('bkgqs,bskd->bqkgd', p, v)

    o = lax.map(block, qb)
    return o.transpose(1, 0, 2, 3, 4, 5).reshape(B, L, N_HEADS * HEAD_DIM)


def _layer(x, norm_mix_g, w_in, hy_conv_w, hy_conv_b, hy_f_w1, hy_f_b1, hy_f_w2, hy_f_b2,
           hy_f_w3, hy_f_freq, hy_decay, hy_d, q_norm_g, k_norm_g, hy_out_g, att_out_g,
           w_out, norm_ffn_g, w_gate, w_up, w_down):
    B, L, _ = x.shape
    f32 = jnp.float32
    h = _rmsnorm(x, norm_mix_g)
    proj = h @ w_in
    o1 = HY_COLS
    o2 = o1 + Q_COLS
    o3 = o2 + KV_COLS
    u_hy = proj[..., :o1]
    q = proj[..., o1:o2].reshape(B, L, N_HEADS, HEAD_DIM)
    k = proj[..., o2:o3].reshape(B, L, N_KV_HEADS, HEAD_DIM)
    v = proj[..., o3:].reshape(B, L, N_KV_HEADS, HEAD_DIM)
    filt = _hyena_filter(L, hy_f_w1, hy_f_b1, hy_f_w2, hy_f_b2, hy_f_w3, hy_f_freq, hy_decay)
    y_hy = _hyena(u_hy, hy_conv_w, hy_conv_b, filt, hy_d)
    cos, sin = _axial_rope(L)
    q = _apply_rope(_rmsnorm(q, q_norm_g).astype(f32), cos, sin).astype(x.dtype)
    k = _apply_rope(_rmsnorm(k, k_norm_g).astype(f32), cos, sin).astype(x.dtype)
    y_att = _attention(q, k, v)
    mixed = jnp.concatenate([_rmsnorm(y_hy, hy_out_g), _rmsnorm(y_att, att_out_g)], axis=-1) @ w_out
    x = x + mixed
    h = _rmsnorm(x, norm_ffn_g)
    x = x + (jax.nn.silu(h @ w_gate) * (h @ w_up)) @ w_down
    return x


def _trunk(x, layer_params, final_norm_g):
    for l in range(DEPTH):
        x = _layer(x, *[p[l] for p in layer_params])
    return _rmsnorm(x, final_norm_g)


def setup_inputs(seed: int = 0) -> dict:
    key = jax.random.key(seed)
    ks = jax.random.split(key, 24)
    f32 = jnp.float32

    def nrm(k, shape, scale):
        return jax.random.normal(k, shape, f32) * scale

    def gain(k, shape):
        return 1.0 + 0.02 * jax.random.normal(k, shape, f32)

    lo = abs(math.log(DECAY_TARGET)) / SLOW_DECAY_PCT
    hi = abs(math.log(DECAY_TARGET)) / FAST_DECAY_PCT
    decay_base = jnp.linspace(lo, hi, HY_WIDTH, dtype=f32)[None, None, :]
    return {
        'x_prompt': nrm(ks[0], (BATCH, SEQ, D_MODEL), 1.0),
        'x_sample': nrm(ks[1], (DEC_BATCH, DEC_SEQ, D_MODEL), 1.0),
        'norm_mix_g': gain(ks[2], (DEPTH, D_MODEL)),
        'w_in': nrm(ks[3], (DEPTH, D_MODEL, IN_COLS), D_MODEL ** -0.5),
        'hy_conv_w': nrm(ks[4], (DEPTH, SHORT_CONV, HY_COLS), SHORT_CONV ** -0.5),
        'hy_conv_b': nrm(ks[5], (DEPTH, HY_COLS), 0.02),
        'hy_f_w1': nrm(ks[6], (DEPTH, FILTER_EMB, FILTER_HIDDEN), FILTER_EMB ** -0.5),
        'hy_f_b1': nrm(ks[7], (DEPTH, FILTER_HIDDEN), 0.1),
        'hy_f_w2': nrm(ks[8], (DEPTH, FILTER_HIDDEN, FILTER_HIDDEN), FILTER_HIDDEN ** -0.5),
        'hy_f_b2': nrm(ks[9], (DEPTH, FILTER_HIDDEN), 0.1),
        'hy_f_w3': nrm(ks[10], (DEPTH, FILTER_HIDDEN, N_DIRS * HY_WIDTH), FILTER_HIDDEN ** -0.5),
        'hy_f_freq': gain(ks[11], (DEPTH, FILTER_HIDDEN)),
        'hy_decay': decay_base * (1.0 + 0.05 * jax.random.normal(ks[12], (DEPTH, N_DIRS, HY_WIDTH), f32)),
        'hy_d': nrm(ks[13], (DEPTH, HY_WIDTH), 1.0),
        'q_norm_g': gain(ks[14], (DEPTH, HEAD_DIM)),
        'k_norm_g': gain(ks[15], (DEPTH, HEAD_DIM)),
        'hy_out_g': gain(ks[16], (DEPTH, HY_WIDTH)),
        'att_out_g': gain(ks[17], (DEPTH, ATT_WIDTH)),
        'w_out': nrm(ks[18], (DEPTH, MIX_WIDTH, D_MODEL), MIX_WIDTH ** -0.5),
        'norm_ffn_g': gain(ks[19], (DEPTH, D_MODEL)),
        'w_gate': nrm(ks[20], (DEPTH, D_MODEL, D_FF), D_MODEL ** -0.5),
        'w_up': nrm(ks[21], (DEPTH, D_MODEL, D_FF), D_MODEL ** -0.5),
        'w_down': nrm(ks[22], (DEPTH, D_FF, D_MODEL), D_FF ** -0.5),
        'final_norm_g': gain(ks[23], (D_MODEL,)),
    }


def reference(x_prompt, x_sample, norm_mix_g, w_in, hy_conv_w, hy_conv_b, hy_f_w1, hy_f_b1,
              hy_f_w2, hy_f_b2, hy_f_w3, hy_f_freq, hy_decay, hy_d, q_norm_g, k_norm_g,
              hy_out_g, att_out_g, w_out, norm_ffn_g, w_gate, w_up, w_down, final_norm_g):
    layer_params = (norm_mix_g, w_in, hy_conv_w, hy_conv_b, hy_f_w1, hy_f_b1, hy_f_w2, hy_f_b2,
                    hy_f_w3, hy_f_freq, hy_decay, hy_d, q_norm_g, k_norm_g, hy_out_g, att_out_g,
                    w_out, norm_ffn_g, w_gate, w_up, w_down)
    y_prompt = _trunk(x_prompt, layer_params, final_norm_g)
    y_sample = _trunk(x_sample, layer_params, final_norm_g)
    return (y_prompt, y_sample)
```

```cpp
#include <hip/hip_runtime.h>
#include <hip/hip_cooperative_groups.h>
#include <cstdio>
#include <cstdint>
namespace cg = cooperative_groups;
namespace pg8 {
#define PG8_LAS __attribute__((address_space(3)))
typedef unsigned short bf16_t;
typedef short bf16x8 __attribute__((ext_vector_type(8)));
typedef float f32x4 __attribute__((ext_vector_type(4)));
typedef unsigned u32x4 __attribute__((ext_vector_type(4)));
constexpr int BM = 256, BK = 64, HALF = 128, HTB = HALF * BK * 2  , STAGE_BYTES = 8 * HTB, NXCD = 8, WGM = 8;

__host__ __device__ __forceinline__ int lds_byte(int r, int c) { const int st = (r >> 4) * 2 + (c >> 5), rr = r & 15, cc = c & 31, ob = rr * 64 + cc * 2; return st * 1024 + (ob ^ (((ob >> 9) & 1) << 5)); }
__host__ __device__ __forceinline__ void stage_rc(int b, int& R, int& C) { const int st = b / 1024, sb = b % 1024, swz = sb ^ (((sb >> 9) & 1) << 5); R = (st >> 1) * 16 + swz / 64; C = (st & 1) * 32 + (swz % 64) / 2; }
__host__ __device__ __forceinline__ int perm32(int rho) { const int n = rho >> 4, i = rho & 15; return 8 * (i >> 2) + 4 * n + (i & 3); }

struct Unit { int pm, pn; };
struct Gemm { const bf16_t* A; const bf16_t* Bt; int M, N, K; };

struct StaticOrder {
    int nM, nN, nwg, G, c;
    __host__ __device__ void init(int M, int N, int G_, int c_) { nM = M / BM; nN = N / BM; nwg = nM * nN; G = G_; c = c_; }
    __host__ __device__ bool next(int i, Unit& u) const {
        const long L = (long)i * G + c; if (L >= nwg) return false;
        int wgid = (int)L; { const int q = nwg / NXCD, r = nwg % NXCD, xcd = wgid % NXCD, off = wgid / NXCD; wgid = (xcd < r ? xcd * (q + 1) : r * (q + 1) + (xcd - r) * q) + off; }
        const int nig = WGM * nN, gid = wgid / nig, fm = gid * WGM, gsz = (nM - fm) < WGM ? (nM - fm) : WGM;
        u.pm = fm + ((wgid % nig) % gsz); u.pn = (wgid % nig) / gsz; return true;
    }
    __device__ __forceinline__ void a_ready(const Unit&) const {}
    __device__ __forceinline__ void done(const Unit&) const {}
};

__device__ __forceinline__ unsigned cvt_pk_bf16(float lo, float hi) { unsigned r; asm volatile("v_cvt_pk_bf16_f32 %0, %1, %2" : "=v"(r) : "v"(lo), "v"(hi)); return r; }
typedef float f32x2 __attribute__((ext_vector_type(2)));
__device__ __forceinline__ f32x2 gelu_pk(f32x2 v) {
    const f32x2 av = __builtin_elementwise_abs(v), d = av * 0.2316418882f + 1.0f;
    f32x2 t; t.x = __builtin_amdgcn_rcpf(d.x); t.y = __builtin_amdgcn_rcpf(d.y);
    f32x2 q = t * 0.5307027145f + (-0.7265760135f); q = q * t + 0.7107068705f; q = q * t + (-0.142248368f); q = q * t + 0.127414796f; q = q * t;
    const f32x2 s = (v * v) * (-0.72134752044f);
    f32x2 e; e.x = __builtin_amdgcn_exp2f(s.x); e.y = __builtin_amdgcn_exp2f(s.y);
    const f32x2 m = v * (q * e), r = v - m;
    f32x2 o; o.x = v.x < 0.f ? m.x : r.x; o.y = v.y < 0.f ? m.y : r.y; return o;
}

template <int ACT  > struct EpiBf16 {
    static constexpr bool PERM = true, AFTER_DRAIN = false; static_assert(ACT == 0 || ACT == 1, "EpiBf16: ACT is 0 (none) or 1 (gelu_pk)");
    bf16_t* O; int ldc; const float* bias; int split_cols; size_t split_stride; float scale0;
    __device__ __forceinline__ void operator()(const f32x4 (&acc)[2][2][4][2], const Unit& u, int wr, int wc, int fr, int fq) const {
        const int row0 = u.pm * BM + wr * 64 + fr; int colt = u.pn * BM; bf16_t* base = O;
        float sc = 1.f; if (split_cols) { const int t = colt / split_cols; base += (size_t)t * split_stride; colt -= t * split_cols; if (t == 0) sc = scale0; }
        const int col0 = colt + wc * 32 + 8 * fq, bcol0 = u.pn * BM + wc * 32 + 8 * fq;
        f32x4 bv[2][2];
#pragma unroll
        for (int bj = 0; bj < 2; ++bj)
#pragma unroll
            for (int n = 0; n < 2; ++n) bv[bj][n] = bias ? *(const f32x4*)(bias + bcol0 + bj * HALF + 4 * n) : (f32x4){0.f, 0.f, 0.f, 0.f};
#pragma unroll
        for (int ai = 0; ai < 2; ++ai)
#pragma unroll
            for (int m = 0; m < 4; ++m) { bf16_t* rowp = base + (size_t)(row0 + ai * HALF + m * 16) * ldc + col0;
#pragma unroll
                for (int bj = 0; bj < 2; ++bj) { f32x4 v0 = acc[ai][bj][m][0] + bv[bj][0], v1 = acc[ai][bj][m][1] + bv[bj][1];
                    if (ACT == 1) { f32x2 a = gelu_pk((f32x2){v0[0], v0[1]}), b = gelu_pk((f32x2){v0[2], v0[3]}), c = gelu_pk((f32x2){v1[0], v1[1]}), d = gelu_pk((f32x2){v1[2], v1[3]});
                        v0 = (f32x4){a.x, a.y, b.x, b.y}; v1 = (f32x4){c.x, c.y, d.x, d.y}; }
                    v0 = v0 * sc; v1 = v1 * sc; u32x4 w; w.x = cvt_pk_bf16(v0[0], v0[1]); w.y = cvt_pk_bf16(v0[2], v0[3]); w.z = cvt_pk_bf16(v1[0], v1[1]); w.w = cvt_pk_bf16(v1[2], v1[3]);
                    *(u32x4*)(rowp + bj * HALF) = w; } }
    }
};

constexpr int TOK_P = 32768;
struct EpiX1 {
    static constexpr bool PERM = true, AFTER_DRAIN = false;
    const float* base0; const float* base1; bf16_t* xb; float* rowsq;
    __device__ __forceinline__ void operator()(const f32x4 (&acc)[2][2][4][2], const Unit& u, int wr, int wc, int fr, int fq) const {
        const int row0 = u.pm * BM + wr * 64 + fr, col0 = u.pn * BM + wc * 32 + 8 * fq;
#pragma unroll
        for (int ai = 0; ai < 2; ++ai)
#pragma unroll
            for (int m = 0; m < 4; ++m) {
                const int r = row0 + ai * HALF + m * 16;
                const float* brow = (r < TOK_P ? base0 + (size_t)r * 1024 : base1 + (size_t)(r - TOK_P) * 1024) + col0;
                float ss = 0.f;
#pragma unroll
                for (int bj = 0; bj < 2; ++bj) {
                    const f32x4 v0 = *(const f32x4*)(brow + bj * HALF) + acc[ai][bj][m][0], v1 = *(const f32x4*)(brow + bj * HALF + 4) + acc[ai][bj][m][1];
                    ss += (v0[0] * v0[0] + v0[1] * v0[1]) + (v0[2] * v0[2] + v0[3] * v0[3]) + (v1[0] * v1[0] + v1[1] * v1[1]) + (v1[2] * v1[2] + v1[3] * v1[3]);
                    u32x4 w; w.x = cvt_pk_bf16(v0[0], v0[1]); w.y = cvt_pk_bf16(v0[2], v0[3]); w.z = cvt_pk_bf16(v1[0], v1[1]); w.w = cvt_pk_bf16(v1[2], v1[3]);
                    *(u32x4*)(xb + (size_t)r * 1024 + col0 + bj * HALF) = w;
                }
                ss += __shfl_xor(ss, 16); ss += __shfl_xor(ss, 32);
                if (fq == 0) unsafeAtomicAdd(rowsq + r, ss);
            }
    }
};
struct EpiY {
    static constexpr bool PERM = true, AFTER_DRAIN = false;
    bf16_t* xb; float* rowsq;
    __device__ __forceinline__ void operator()(const f32x4 (&acc)[2][2][4][2], const Unit& u, int wr, int wc, int fr, int fq) const {
        const int row0 = u.pm * BM + wr * 64 + fr, col0 = u.pn * BM + wc * 32 + 8 * fq;
#pragma unroll
        for (int ai = 0; ai < 2; ++ai)
#pragma unroll
            for (int m = 0; m < 4; ++m) {
                const int r = row0 + ai * HALF + m * 16;
                bf16_t* prow = xb + (size_t)r * 1024 + col0;
                float ss = 0.f;
#pragma unroll
                for (int bj = 0; bj < 2; ++bj) {
                    const u32x4 x = *(const u32x4*)(prow + bj * HALF);
                    f32x4 v0 = acc[ai][bj][m][0], v1 = acc[ai][bj][m][1];
                    v0[0] += __builtin_bit_cast(float, x.x << 16); v0[1] += __builtin_bit_cast(float, x.x & 0xffff0000u); v0[2] += __builtin_bit_cast(float, x.y << 16); v0[3] += __builtin_bit_cast(float, x.y & 0xffff0000u);
                    v1[0] += __builtin_bit_cast(float, x.z << 16); v1[1] += __builtin_bit_cast(float, x.z & 0xffff0000u); v1[2] += __builtin_bit_cast(float, x.w << 16); v1[3] += __builtin_bit_cast(float, x.w & 0xffff0000u);
                    ss += (v0[0] * v0[0] + v0[1] * v0[1]) + (v0[2] * v0[2] + v0[3] * v0[3]) + (v1[0] * v1[0] + v1[1] * v1[1]) + (v1[2] * v1[2] + v1[3] * v1[3]);
                    u32x4 w; w.x = cvt_pk_bf16(v0[0], v0[1]); w.y = cvt_pk_bf16(v0[2], v0[3]); w.z = cvt_pk_bf16(v1[0], v1[1]); w.w = cvt_pk_bf16(v1[2], v1[3]);
                    *(u32x4*)(prow + bj * HALF) = w;
                }
                ss += __shfl_xor(ss, 16); ss += __shfl_xor(ss, 32);
                if (fq == 0) unsafeAtomicAdd(rowsq + r, ss);
            }
    }
};
struct EpiSwiGLU {
    static constexpr bool PERM = true, AFTER_DRAIN = false;
    bf16_t* act; const float* rowsq; int ldc; float eps;
    __device__ __forceinline__ void operator()(const f32x4 (&acc)[2][2][4][2], const Unit& u, int wr, int wc, int fr, int fq) const {
        const int row0 = u.pm * BM + wr * 64 + fr, col0 = u.pn * HALF + wc * 32 + 8 * fq;
#pragma unroll
        for (int ai = 0; ai < 2; ++ai)
#pragma unroll
            for (int m = 0; m < 4; ++m) {
                const int r = row0 + ai * HALF + m * 16;
                const float rstd = __builtin_amdgcn_rsqf(rowsq[r] * (1.0f / 1024.0f) + eps);
                float o[8];
#pragma unroll
                for (int n = 0; n < 2; ++n)
#pragma unroll
                    for (int i = 0; i < 4; ++i) {
                        const float g = acc[ai][0][m][n][i] * rstd, up = acc[ai][1][m][n][i] * rstd;
                        const float sg = g * __builtin_amdgcn_rcpf(1.0f + __builtin_amdgcn_exp2f(-1.4426950408889634f * g));
                        o[n * 4 + i] = sg * up;
                    }
                u32x4 w; w.x = cvt_pk_bf16(o[0], o[1]); w.y = cvt_pk_bf16(o[2], o[3]); w.z = cvt_pk_bf16(o[4], o[5]); w.w = cvt_pk_bf16(o[6], o[7]);
                *(u32x4*)(act + (size_t)r * ldc + col0) = w;
            }
    }
};

template <class Epi, class Sched, bool ALIGN_EPI = false, bool SP2 = false>
__device__ __forceinline__ void gemm_phase(PG8_LAS unsigned char* lds, const Gemm g, const Sched& S, const Epi& E) {
    const int tid = threadIdx.x, wid = __builtin_amdgcn_readfirstlane(tid >> 6), lane = tid & 63, wr = wid >> 2, wc = wid & 3, fr = lane & 15, fq = lane >> 4;
    const int K = g.K, nt = K / BK;
    unsigned voffA[2], voffB[2];
#pragma unroll
    for (int i = 0; i < 2; ++i) { int R, C; stage_rc(tid * 16 + i * 8192, R, C); const int Rb = Epi::PERM ? ((R & ~31) + perm32(R & 31)) : R;
        voffA[i] = (unsigned)(R * K + C) * 2u; voffB[i] = (unsigned)(Rb * K + C) * 2u; }
    const size_t kstep = (size_t)(BK * 2);
    const size_t hstep = (size_t)HALF * K * 2;
    const size_t tstep = 2 * hstep;
    const unsigned ldsw = (unsigned)wid * 1024u;
    const int aoff = lds_byte(wr * 64 + fr, fq * 8), boff = lds_byte(wc * 32 + fr, fq * 8);
#define PG8_SA(b, h) (((b) * 2 + (h)) * HTB)
#define PG8_SB(b, h) ((4 + (b) * 2 + (h)) * HTB)
#define PG8_STAGE(bufoff, gbase, voff) do { _Pragma("unroll") for (int _i = 0; _i < 2; ++_i) \
        __builtin_amdgcn_global_load_lds((const unsigned*)((const char*)(gbase) + (voff)[_i]), (PG8_LAS unsigned*)(lds + (bufoff) + ldsw + _i * 8192), 16, 0, 0); } while (0)
#define PG8_LDA(dst, b, h) do { _Pragma("unroll") for (int m = 0; m < 4; ++m) _Pragma("unroll") for (int k = 0; k < 2; ++k) dst[m][k] = *(const PG8_LAS bf16x8*)(lds + PG8_SA(b, h) + aoff + m * 2048 + k * 1024); } while (0)
#define PG8_LDB(dst, b, h) do { _Pragma("unroll") for (int n = 0; n < 2; ++n) _Pragma("unroll") for (int k = 0; k < 2; ++k) dst[n][k] = *(const PG8_LAS bf16x8*)(lds + PG8_SB(b, h) + boff + n * 2048 + k * 1024); } while (0)
#define PG8_MMA(ai, bj, At, Bt) do { __builtin_amdgcn_s_setprio(1); _Pragma("unroll") for (int m = 0; m < 4; ++m) _Pragma("unroll") for (int n = 0; n < 2; ++n) _Pragma("unroll") for (int k = 0; k < 2; ++k) \
        acc[ai][bj][m][n] = __builtin_amdgcn_mfma_f32_16x16x32_bf16(Bt[n][k], At[m][k], acc[ai][bj][m][n], 0, 0, 0); __builtin_amdgcn_s_setprio(0); } while (0)
#define PG8_WAIT_V(n) asm volatile("s_waitcnt vmcnt(" #n ")" ::: "memory")
#define PG8_WAIT_L(n) asm volatile("s_waitcnt lgkmcnt(" #n ")" ::: "memory")
#define PG8_BAR __builtin_amdgcn_s_barrier()
#define PG8_SCHED __builtin_amdgcn_sched_barrier(0)
    Unit cur, nxt; int ui = 0;
    if (!S.next(0, cur)) return;
    f32x4 acc[2][2][4][2];
#pragma unroll
    for (int a = 0; a < 2; ++a)
#pragma unroll
        for (int b = 0; b < 2; ++b)
#pragma unroll
            for (int m = 0; m < 4; ++m)
#pragma unroll
                for (int n = 0; n < 2; ++n) acc[a][b][m][n] = (f32x4){0.f, 0.f, 0.f, 0.f};
    bf16x8 At[4][2], B0[2][2], B1[2][2];
    const char* cA = (const char*)g.A + (size_t)cur.pm * tstep; const char* cB = (const char*)g.Bt + (size_t)cur.pn * tstep;
    S.a_ready(cur);
    if constexpr (SP2) {
        PG8_STAGE(PG8_SB(0, 0), cB, voffB); PG8_STAGE(PG8_SB(0, 1), cB + hstep, voffB); PG8_STAGE(PG8_SA(0, 0), cA, voffA); PG8_STAGE(PG8_SA(0, 1), cA + hstep, voffA);
        if (wr == 1) PG8_BAR;
        PG8_WAIT_V(2); PG8_BAR;
        PG8_STAGE(PG8_SB(1, 0), cB + kstep, voffB); PG8_STAGE(PG8_SA(1, 0), cA + kstep, voffA); PG8_STAGE(PG8_SB(1, 1), cB + hstep + kstep, voffB);
        PG8_WAIT_V(6); PG8_BAR;
    } else {
        PG8_STAGE(PG8_SB(0, 0), cB, voffB); PG8_STAGE(PG8_SA(0, 0), cA, voffA); PG8_STAGE(PG8_SB(0, 1), cB + hstep, voffB); PG8_STAGE(PG8_SA(0, 1), cA + hstep, voffA);
        if (wr == 1) PG8_BAR;
        PG8_WAIT_V(4); PG8_BAR;
        PG8_STAGE(PG8_SB(1, 0), cB + kstep, voffB); PG8_STAGE(PG8_SA(1, 0), cA + kstep, voffA); PG8_STAGE(PG8_SB(1, 1), cB + hstep + kstep, voffB);
        PG8_WAIT_V(6); PG8_BAR;
    }
    for (;;) {
        const bool has_next = S.next(ui + 1, nxt);
        const char* nA = has_next ? (const char*)g.A + (size_t)nxt.pm * tstep : cA; const char* nB = has_next ? (const char*)g.Bt + (size_t)nxt.pn * tstep : cB;
        for (int t = 0; t < nt; t += 2) {
            const bool last = (t == nt - 2);
            const char* a1 = cA + (size_t)(t + 1) * kstep;
            const char* a2 = last ? nA : cA + (size_t)(t + 2) * kstep; const char* b2 = last ? nB : cB + (size_t)(t + 2) * kstep;
            const char* a3 = a2 + kstep; const char* b3 = b2 + kstep;
            if (last && has_next) S.a_ready(nxt);
            if constexpr (SP2) {
            PG8_LDB(B0, 0, 0); PG8_LDB(B1, 0, 1); PG8_SCHED; PG8_LDA(At, 0, 0); PG8_STAGE(PG8_SA(1, 1), a1 + hstep, voffA);
            PG8_WAIT_V(8); PG8_WAIT_L(0); PG8_BAR; PG8_MMA(0, 0, At, B0); PG8_MMA(0, 1, At, B1); PG8_BAR; PG8_SCHED;
            PG8_LDA(At, 0, 1); PG8_STAGE(PG8_SB(0, 0), b2, voffB); PG8_STAGE(PG8_SB(0, 1), b2 + hstep, voffB); PG8_STAGE(PG8_SA(0, 0), a2, voffA);
            PG8_WAIT_V(8); PG8_WAIT_L(0); PG8_BAR; PG8_MMA(1, 0, At, B0); PG8_MMA(1, 1, At, B1); PG8_BAR; PG8_SCHED;
            PG8_LDB(B0, 1, 0); PG8_LDB(B1, 1, 1); PG8_SCHED; PG8_LDA(At, 1, 0); PG8_STAGE(PG8_SA(0, 1), a2 + hstep, voffA);
            PG8_WAIT_V(8); PG8_WAIT_L(0); PG8_BAR; PG8_MMA(0, 0, At, B0); PG8_MMA(0, 1, At, B1); PG8_BAR; PG8_SCHED;
            PG8_LDA(At, 1, 1); PG8_STAGE(PG8_SB(1, 0), b3, voffB); PG8_STAGE(PG8_SB(1, 1), b3 + hstep, voffB); PG8_STAGE(PG8_SA(1, 0), a3, voffA);
            PG8_WAIT_V(8); PG8_WAIT_L(0); PG8_BAR; PG8_MMA(1, 0, At, B0); PG8_MMA(1, 1, At, B1); PG8_BAR; PG8_SCHED;
            } else {
            PG8_LDB(B0, 0, 0); PG8_SCHED; PG8_LDA(At, 0, 0); PG8_STAGE(PG8_SA(1, 1), a1 + hstep, voffA);
            PG8_WAIT_L(8); PG8_BAR; PG8_WAIT_L(0); PG8_MMA(0, 0, At, B0); PG8_BAR; PG8_SCHED;
            PG8_LDB(B1, 0, 1); PG8_STAGE(PG8_SB(0, 0), b2, voffB);
            PG8_BAR; PG8_WAIT_L(0); PG8_MMA(0, 1, At, B1); PG8_BAR;
            PG8_LDA(At, 0, 1); PG8_STAGE(PG8_SA(0, 0), a2, voffA);
            PG8_BAR; PG8_WAIT_L(0); PG8_MMA(1, 0, At, B0); PG8_BAR; PG8_SCHED;
            PG8_STAGE(PG8_SB(0, 1), b2 + hstep, voffB);
            PG8_WAIT_V(6); PG8_BAR; PG8_MMA(1, 1, At, B1); PG8_BAR;
            PG8_LDB(B0, 1, 0); PG8_SCHED; PG8_LDA(At, 1, 0); PG8_STAGE(PG8_SA(0, 1), a2 + hstep, voffA);
            PG8_WAIT_L(8); PG8_BAR; PG8_WAIT_L(0); PG8_MMA(0, 0, At, B0); PG8_BAR; PG8_SCHED;
            PG8_LDB(B1, 1, 1); PG8_STAGE(PG8_SB(1, 0), b3, voffB);
            PG8_BAR; PG8_WAIT_L(0); PG8_MMA(0, 1, At, B1); PG8_BAR;
            PG8_LDA(At, 1, 1); PG8_STAGE(PG8_SA(1, 0), a3, voffA);
            PG8_BAR; PG8_WAIT_L(0); PG8_MMA(1, 0, At, B0); PG8_BAR; PG8_SCHED;
            PG8_STAGE(PG8_SB(1, 1), b3 + hstep, voffB);
            PG8_WAIT_V(6); PG8_BAR; PG8_MMA(1, 1, At, B1); PG8_BAR;
            }
        }
        if constexpr (ALIGN_EPI) { if (wr == 0) PG8_BAR; }
        if constexpr (!Epi::AFTER_DRAIN) { E(acc, cur, wr, wc, fr, fq); S.done(cur); }
        if (!has_next) break;
#pragma unroll
        for (int a = 0; a < 2; ++a)
#pragma unroll
            for (int b = 0; b < 2; ++b)
#pragma unroll
                for (int m = 0; m < 4; ++m)
#pragma unroll
                    for (int n = 0; n < 2; ++n) acc[a][b][m][n] = (f32x4){0.f, 0.f, 0.f, 0.f};
        cur = nxt; cA = nA; cB = nB; ++ui;
        if constexpr (ALIGN_EPI) { if (wr == 1) PG8_BAR; }
    }
    PG8_WAIT_V(0);
    if constexpr (!ALIGN_EPI) { if (wr == 0) PG8_BAR; }
    PG8_BAR;
    if constexpr (Epi::AFTER_DRAIN) { E.fused(acc, cur, wr, wc, fr, fq, lds, wid, lane); S.done(cur); }
#undef PG8_SA
#undef PG8_SB
#undef PG8_STAGE
#undef PG8_LDA
#undef PG8_LDB
#undef PG8_MMA
#undef PG8_WAIT_V
#undef PG8_WAIT_L
#undef PG8_BAR
#undef PG8_SCHED
}
}

#ifndef PG8_SP2
#define PG8_SP2 true
#endif
#ifndef PG8_ALIGN
#define PG8_ALIGN true
#endif
#include <hip/hip_bf16.h>
#include <cmath>
namespace attn_body {
using bf16=__hip_bfloat16;
using bf16x8=__attribute__((ext_vector_type(8)))short;
using s16x4=__attribute__((ext_vector_type(4)))short;
using f32x16=__attribute__((ext_vector_type(16)))float;
using u32x4=__attribute__((ext_vector_type(4)))unsigned;
constexpr int D=64,QP=512,KP=64;
constexpr int NW=8,QBLK=32,QB=QBLK*NW,KVBLK=64;
constexpr int ATTN_UNIT_ROWS=QB;
__device__ __forceinline__ int crow(int r,int hi){return (r&3)+8*(r>>2)+4*hi;}
#define SBAR() __builtin_amdgcn_sched_barrier(0)
__device__ __forceinline__ void cmask(f32x16&p0,f32x16&p1,int jb,int qrel,int hi){
  const float NEG=-INFINITY; int kb=64*jb+4*hi;
  #pragma unroll
  for(int r=0;r<16;++r){int kv=kb+(r&3)+8*(r>>2); if(kv>qrel)p0[r]=NEG; if(kv+32>qrel)p1[r]=NEG;}
}

constexpr int NSLOT=3, SLOTB=8192;
constexpr int LDS_K=0, LDS_V=NSLOT*SLOTB, LDS_WS=2*NSLOT*SLOTB, LDS_OST=LDS_WS+NW*64*4, LDS_BYTES=LDS_OST+NW*4096;
constexpr float C2=0.125f*1.4426950408889634f;
__device__ __forceinline__ void glds16(const void*gsrc,unsigned lds_dst){unsigned keep;
  asm volatile("s_mov_b32 %0, m0\n\ts_mov_b32 m0, %2\n\ts_nop 0\n\tglobal_load_lds_dwordx4 %1, off\n\ts_mov_b32 m0, %0":"=&s"(keep):"v"(gsrc),"s"(lds_dst):"memory");}
__device__ __forceinline__ float max3f(float a,float b,float c){float r;asm("v_max3_f32 %0, %1, %2, %3":"=v"(r):"v"(a),"v"(b),"v"(c));return r;}
__device__ __forceinline__ float max2f(float a,float b){float r;asm("v_max_f32_e32 %0, %1, %2":"=v"(r):"v"(a),"v"(b));return r;}
__device__ __forceinline__ float fadd_s(float a,float b){float r;asm("v_add_f32_e32 %0, %1, %2":"=v"(r):"v"(a),"v"(b));return r;}
__device__ __forceinline__ float fsub_s(float a,float b){float r;asm("v_sub_f32_e32 %0, %1, %2":"=v"(r):"v"(a),"v"(b));return r;}
typedef float f32x2_t __attribute__((ext_vector_type(2))); typedef __bf16 bf16x2_t __attribute__((ext_vector_type(2)));
__device__ __forceinline__ unsigned cvtpk_s(float lo,float hi){f32x2_t v={lo,hi};bf16x2_t b=__builtin_convertvector(v,bf16x2_t);return __builtin_bit_cast(unsigned,b);}
#define WAIT_BAR(N) asm volatile("s_waitcnt vmcnt(" #N ") lgkmcnt(0)\n\ts_barrier":::"memory")

__device__ __forceinline__ void qkt(f32x16&p0,f32x16&p1,const char*Kslot,const bf16x8*qr,const f32x16&negm,int r32,int hi){
  const char*kb=Kslot+hi*1024+r32*16;
  #pragma unroll
  for(int d0=0;d0<4;++d0){
    const bf16x8 b0=*reinterpret_cast<const bf16x8*>(kb+d0*2048);
    const bf16x8 b1=*reinterpret_cast<const bf16x8*>(kb+d0*2048+512);
    if(d0==0){p0=__builtin_amdgcn_mfma_f32_32x32x16_bf16(b0,qr[0],negm,0,0,0);p1=__builtin_amdgcn_mfma_f32_32x32x16_bf16(b1,qr[0],negm,0,0,0);}
    else{p0=__builtin_amdgcn_mfma_f32_32x32x16_bf16(b0,qr[d0],p0,0,0,0);p1=__builtin_amdgcn_mfma_f32_32x32x16_bf16(b1,qr[d0],p1,0,0,0);}}
}
typedef __attribute__((address_space(3))) const char* lds_cptr;
typedef short v4i16_t __attribute__((ext_vector_type(4)));
__device__ __forceinline__ void kload8(bf16x8*kf,lds_cptr kp){
  kf[0]=*(const __attribute__((address_space(3))) bf16x8*)(kp);      kf[1]=*(const __attribute__((address_space(3))) bf16x8*)(kp+512);
  kf[2]=*(const __attribute__((address_space(3))) bf16x8*)(kp+2048); kf[3]=*(const __attribute__((address_space(3))) bf16x8*)(kp+2560);
  kf[4]=*(const __attribute__((address_space(3))) bf16x8*)(kp+4096); kf[5]=*(const __attribute__((address_space(3))) bf16x8*)(kp+4608);
  kf[6]=*(const __attribute__((address_space(3))) bf16x8*)(kp+6144); kf[7]=*(const __attribute__((address_space(3))) bf16x8*)(kp+6656);
}
__device__ __forceinline__ void kload2(bf16x8*kf,lds_cptr kp,int j){ kf[2*j]=*(const __attribute__((address_space(3))) bf16x8*)(kp+j*2048); kf[2*j+1]=*(const __attribute__((address_space(3))) bf16x8*)(kp+j*2048+512); }
__device__ __forceinline__ s16x4 vtr(lds_cptr p){ return __builtin_bit_cast(s16x4,__builtin_amdgcn_ds_read_tr16_b64_v4i16((__attribute__((address_space(3))) v4i16_t*)p)); }
__device__ __forceinline__ float rowmax(const f32x16&p0,const f32x16&p1){
  float a=max3f(p0[0],p0[1],p1[0]),b=max3f(p0[2],p0[3],p1[1]);a=max3f(a,p1[2],p1[3]);
  #pragma unroll
  for(int r=4;r<16;r+=4){a=max3f(a,p0[r],p0[r+1]);b=max3f(b,p0[r+2],p0[r+3]);a=max3f(a,p1[r],p1[r+1]);b=max3f(b,p1[r+2],p1[r+3]);}
  const float m=max2f(a,b);
  auto rr=__builtin_amdgcn_permlane32_swap(__float_as_uint(m),__float_as_uint(m),false,false);
  return max2f(__uint_as_float(rr[0]),__uint_as_float(rr[1]));
}
__device__ __forceinline__ void pv(f32x16*o,int vb,bf16x8 pa0,bf16x8 pa1,bf16x8 pa2,bf16x8 pa3){
  #pragma unroll
  for(int d0=0;d0<2;++d0){s16x4 lo[4],hi[4];
    #pragma unroll
    for(int ks=0;ks<4;++ks){
      asm volatile("ds_read_b64_tr_b16 %0,%1 offset:%c2":"=&v"(lo[ks]):"v"(vb),"i"(d0*4096+ks*1024):"memory");
      asm volatile("ds_read_b64_tr_b16 %0,%1 offset:%c2":"=&v"(hi[ks]):"v"(vb),"i"(d0*4096+ks*1024+512):"memory");}
    asm volatile("s_waitcnt lgkmcnt(0)":::"memory");SBAR();
    #define PK(k) (bf16x8){lo[k][0],lo[k][1],lo[k][2],lo[k][3],hi[k][0],hi[k][1],hi[k][2],hi[k][3]}
    o[d0]=__builtin_amdgcn_mfma_f32_32x32x16_bf16(pa0,PK(0),o[d0],0,0,0);
    o[d0]=__builtin_amdgcn_mfma_f32_32x32x16_bf16(pa1,PK(1),o[d0],0,0,0);
    o[d0]=__builtin_amdgcn_mfma_f32_32x32x16_bf16(pa2,PK(2),o[d0],0,0,0);
    o[d0]=__builtin_amdgcn_mfma_f32_32x32x16_bf16(pa3,PK(3),o[d0],0,0,0);
    #undef PK
  }
}

#ifndef ATTN_STORE16
#define ATTN_STORE16(p,v) (*(u32x4*)(p)=(v))
#endif
template<int THRL> __device__ __forceinline__ void attn_unit(long qrow0,long kvrow0,int seq,int h,const bf16*Q,const bf16*__restrict__ K,const bf16*__restrict__ V,bf16*O,char*shm,long kvhstride,float mref){
  const int tid=threadIdx.x,lane=tid&63,r32=lane&31,hi=lane>>5; const int wid=__builtin_amdgcn_readfirstlane(tid>>6);
  const bf16*Qw=Q+(qrow0+wid*QBLK)*QP+h*D;
  const bf16*Kh=K+((long)(h>>2)*kvhstride+kvrow0)*KP,*Vh=V+((long)(h>>2)*kvhstride+kvrow0)*KP;
  const unsigned lds0=(unsigned)(uintptr_t)shm;
  float*wsf=(float*)(shm+LDS_WS)+wid*64;
  const bf16*ksrc=Kh+(long)lane*KP+wid*8;
  const bf16*vsrc=Vh+(long)(16*(wid&3)+(lane>>2))*KP+(wid>>2)*32+(lane&3)*8;
  const unsigned kdst=lds0+LDS_K+wid*1024, vdst=lds0+LDS_V+wid*1024;
  #define DMA_K(t,slot) glds16(ksrc+(long)(t)*KVBLK*KP,(unsigned)__builtin_amdgcn_readfirstlane(kdst+(slot)))
  #define DMA_V(t,slot) glds16(vsrc+(long)(t)*KVBLK*KP,(unsigned)__builtin_amdgcn_readfirstlane(vdst+(slot)))
  const int vb0=(int)(lds0+LDS_V)+((lane>>4)&1)*32+(lane&3)*8+(4*hi+((lane&15)>>2))*64;
  const char*Kbase=shm+LDS_K; bf16x8 kf[8];
  const lds_cptr shm3=(lds_cptr)shm; const lds_cptr kp0=shm3+LDS_K+hi*1024+r32*16; const lds_cptr vp0=shm3+LDS_V+((lane>>4)&1)*32+(lane&3)*8+(4*hi+((lane&15)>>2))*64;
  const int NT=seq/KVBLK;
  DMA_K(0,0);DMA_V(0,0);DMA_K(1,SLOTB);
  bf16x8 qr[4];
  #pragma unroll
  for(int d0=0;d0<4;++d0)qr[d0]=*reinterpret_cast<const bf16x8*>(&Qw[(long)r32*QP+d0*16+hi*8]);
  float l_reg=0.f;f32x16 o[2];o[0]=f32x16{};o[1]=f32x16{};f32x16 negm;
  #pragma unroll
  for(int r=0;r<16;++r)negm[r]=-mref;
  asm volatile("":"+v"(negm));
  #define CMASK(P0,P1,t) do{}while(0)
  bool resc=false;
  #define START(P0,P1) do{ resc=false; _Pragma("unroll") for(int r=0;r<16;++r)P0[r]=__builtin_amdgcn_exp2f(P0[r]); }while(0)
  #define RESC() do{ if(resc){ asm volatile("s_waitcnt lgkmcnt(0)":::"memory"); \
      _Pragma("unroll") for(int d_=0;d_<2;++d_) _Pragma("unroll") for(int r=0;r<16;++r)o[d_][r]*=wsf[crow(r,hi)]; } }while(0)
  f32x16 pA0,pA1,pB0,pB1;
  int sl_prev=0,sl_cur=0,sl_next=SLOTB;
  #define ROT() do{sl_prev=sl_cur;sl_cur=sl_next;sl_next=(sl_next==(NSLOT-1)*SLOTB)?0:sl_next+SLOTB;}while(0)
  DMA_K(2,2*SLOTB);
  WAIT_BAR(3);
  qkt(pA0,pA1,Kbase,qr,negm,r32,hi);asm volatile("s_nop 15\n\ts_nop 7":"+v"(pA0),"+v"(pA1));CMASK(pA0,pA1,0);
  START(pA0,pA1);
  _Pragma("unroll") for(int r=0;r<16;++r)pA1[r]=__builtin_amdgcn_exp2f(pA1[r]);
  WAIT_BAR(0);
  DMA_K(3,0);DMA_V(1,SLOTB);
  ROT();
  kload8(kf,kp0+sl_cur);
  WAIT_BAR(2);
  s16x4 vlo[8],vhi[8]; u32x4 pw0,pw1,pw2,pw3;
  #define PKW(P,B) cvtpk_s(P[B],P[B+1])
  #define PAF(k) __builtin_bit_cast(bf16x8,pw##k)
  #define VFR(i) (bf16x8){vlo[i][0],vlo[i][1],vlo[i][2],vlo[i][3],vhi[i][0],vhi[i][1],vhi[i][2],vhi[i][3]}
  #define PIN(x) asm volatile("":"+v"(x))
  #define MX3(a,b,c) __builtin_fmaxf(__builtin_fmaxf((a),(b)),(c))
  #define GAPA(MF,A0,A1,A2,A3,W0,W1,PW) do{ MF; sacc+=A0; sacc+=A1; sacc+=A2; sacc+=A3; PIN(sacc); W0; W1; PIN(PW); SBAR(); }while(0)
  #define EX(v) __builtin_amdgcn_exp2f(v)
  #define GAPB(MF,X,B) do{ MF; X[B]=EX(X[B]); X[B+1]=EX(X[B+1]); X[B+2]=EX(X[B+2]); X[B+3]=EX(X[B+3]); PIN(X); SBAR(); }while(0)
  #define VRD(i) do{ vlo[i]=vtr(vp_+(((i)>>2)*4096+((i)&3)*1024)); vhi[i]=vtr(vp_+(((i)>>2)*4096+((i)&3)*1024+512)); }while(0)
  #define KRD(G,j) do{ if(G){ kload2(kf,kp0+sl_next,j); SBAR(); } }while(0)
  #define STEP(C0,C1,P0,P1,t,GK,GV,GL) do{ SBAR(); \
    const lds_cptr vp_=vp0+sl_prev; \
    VRD(0); SBAR(); float sacc=(P0[0]+P0[1]); \
    GAPA(C0=__builtin_amdgcn_mfma_f32_32x32x16_bf16(kf[0],qr[0],negm,0,0,0), P0[2],P0[3],P0[4],P0[5],     pw0[0]=PKW(P0,0), pw0[1]=PKW(P0,2), pw0); \
    VRD(4); SBAR(); GAPA(C1=__builtin_amdgcn_mfma_f32_32x32x16_bf16(kf[1],qr[0],negm,0,0,0), P0[6],P0[7],P0[8],P0[9],     pw0[2]=PKW(P0,4), pw0[3]=PKW(P0,6), pw0); \
    VRD(1); SBAR(); GAPA(C0=__builtin_amdgcn_mfma_f32_32x32x16_bf16(kf[2],qr[1],C0,0,0,0),   P0[10],P0[11],P0[12],P0[13], pw1[0]=PKW(P0,8), pw1[1]=PKW(P0,10), pw1); \
    VRD(5); SBAR(); GAPA(C1=__builtin_amdgcn_mfma_f32_32x32x16_bf16(kf[3],qr[1],C1,0,0,0),   P0[14],P0[15],P1[0],P1[1],   pw1[2]=PKW(P0,12),pw1[3]=PKW(P0,14), pw1); \
    VRD(2); SBAR(); GAPA(C0=__builtin_amdgcn_mfma_f32_32x32x16_bf16(kf[4],qr[2],C0,0,0,0),   P1[2],P1[3],P1[4],P1[5],     pw2[0]=PKW(P1,0), pw2[1]=PKW(P1,2), pw2); \
    VRD(6); SBAR(); GAPA(C1=__builtin_amdgcn_mfma_f32_32x32x16_bf16(kf[5],qr[2],C1,0,0,0),   P1[6],P1[7],P1[8],P1[9],     pw2[2]=PKW(P1,4), pw2[3]=PKW(P1,6), pw2); \
    VRD(3); SBAR(); GAPA(C0=__builtin_amdgcn_mfma_f32_32x32x16_bf16(kf[6],qr[3],C0,0,0,0),   P1[10],P1[11],P1[12],P1[13], pw3[0]=PKW(P1,8), pw3[1]=PKW(P1,10), pw3); \
    VRD(7); SBAR(); GAPA(C1=__builtin_amdgcn_mfma_f32_32x32x16_bf16(kf[7],qr[3],C1,0,0,0),   P1[14],P1[15],0.f,0.f,       pw3[2]=PKW(P1,12),pw3[3]=PKW(P1,14), pw3); \
    l_reg+=sacc; \
    if(GK){DMA_K((t)+3,sl_cur);} if(GV){DMA_V((t)+1,sl_next);} \
    CMASK(C0,C1,t); \
    resc=false;   \
    SBAR(); \
    GAPB(o[0]=__builtin_amdgcn_mfma_f32_32x32x16_bf16(PAF(0),VFR(0),o[0],0,0,0), C0,0); \
    GAPB(o[1]=__builtin_amdgcn_mfma_f32_32x32x16_bf16(PAF(0),VFR(4),o[1],0,0,0), C0,4); \
    KRD(GL,0); GAPB(o[0]=__builtin_amdgcn_mfma_f32_32x32x16_bf16(PAF(1),VFR(1),o[0],0,0,0), C0,8); \
    KRD(GL,1); GAPB(o[1]=__builtin_amdgcn_mfma_f32_32x32x16_bf16(PAF(1),VFR(5),o[1],0,0,0), C0,12); \
    KRD(GL,2); GAPB(o[0]=__builtin_amdgcn_mfma_f32_32x32x16_bf16(PAF(2),VFR(2),o[0],0,0,0), C1,0); \
    KRD(GL,3); GAPB(o[1]=__builtin_amdgcn_mfma_f32_32x32x16_bf16(PAF(2),VFR(6),o[1],0,0,0), C1,4); \
    GAPB(o[0]=__builtin_amdgcn_mfma_f32_32x32x16_bf16(PAF(3),VFR(3),o[0],0,0,0), C1,8); \
    GAPB(o[1]=__builtin_amdgcn_mfma_f32_32x32x16_bf16(PAF(3),VFR(7),o[1],0,0,0), C1,12); \
    }while(0)
  int t=1;
  #undef CMASK
  #define CMASK(P0,P1,t) do{}while(0)
  for(;t+5<NT;t+=2){
    STEP(pB0,pB1,pA0,pA1,t,true,true,true);     WAIT_BAR(2); RESC(); ROT();
    STEP(pA0,pA1,pB0,pB1,t+1,true,true,true);   WAIT_BAR(2); RESC(); ROT();
  }
  #undef CMASK
  #define CMASK(P0,P1,t) do{}while(0)
  #define ENDW(tt) do{ if((tt)+3<NT){WAIT_BAR(2);} else if((tt)+2<NT){WAIT_BAR(1);} else {WAIT_BAR(0);} }while(0)
  for(;t+1<NT;t+=2){
    STEP(pB0,pB1,pA0,pA1,t,(t+3<NT),(t+1<NT),(t+1<NT));       ENDW(t);   RESC(); ROT();
    STEP(pA0,pA1,pB0,pB1,t+1,(t+4<NT),(t+2<NT),(t+2<NT));     ENDW(t+1); RESC(); ROT();
  }
  STEP(pB0,pB1,pA0,pA1,NT-1,false,false,false); RESC();
  { float sacc=pB0[0]+pB0[1]; _Pragma("unroll") for(int r=2;r<16;++r)sacc+=pB0[r]; _Pragma("unroll") for(int r=0;r<16;++r)sacc+=pB1[r]; l_reg+=sacc;
    pw0=(u32x4){PKW(pB0,0),PKW(pB0,2),PKW(pB0,4),PKW(pB0,6)};pw1=(u32x4){PKW(pB0,8),PKW(pB0,10),PKW(pB0,12),PKW(pB0,14)};pw2=(u32x4){PKW(pB1,0),PKW(pB1,2),PKW(pB1,4),PKW(pB1,6)};pw3=(u32x4){PKW(pB1,8),PKW(pB1,10),PKW(pB1,12),PKW(pB1,14)};
    SBAR(); pv(o,vb0+sl_cur,PAF(0),PAF(1),PAF(2),PAF(3)); }
  #undef PKW
  #undef PAF
  #undef VFR
  #undef PIN
  #undef MX3
  #undef GAPA
  #undef GAPB
  #undef EX
  #undef VRD
  #undef KRD
  #undef STEP
  #undef ENDW
  {auto rr=__builtin_amdgcn_permlane32_swap(__float_as_uint(l_reg),__float_as_uint(l_reg),false,false);l_reg=__uint_as_float(rr[0])+__uint_as_float(rr[1]);}
  if(hi==0)wsf[32+r32]=l_reg;asm volatile("s_waitcnt lgkmcnt(0)":::"memory");
  float rli[16];
  #pragma unroll
  for(int r=0;r<16;++r)rli[r]=__builtin_amdgcn_rcpf(wsf[32+crow(r,hi)]);
  bf16*Ow=O+(qrow0+wid*QBLK)*QP+h*D;
  { bf16*stg=(bf16*)(shm+LDS_OST)+wid*2048;
    #pragma unroll
    for(int r=0;r<16;++r){const int orow=crow(r,hi);
      #pragma unroll
      for(int d0=0;d0<2;++d0)stg[orow*64+d0*32+r32]=__float2bfloat16(o[d0][r]*rli[r]);}
    asm volatile("s_waitcnt lgkmcnt(0)":::"memory");
    #pragma unroll
    for(int i=0;i<4;++i){const int row=i*8+(lane>>3),ch=lane&7; const u32x4 v=*(const u32x4*)(stg+row*64+ch*8); ATTN_STORE16(Ow+(long)row*QP+ch*8,v);} }
  asm volatile("s_waitcnt lgkmcnt(0)\n\ts_barrier":::"memory");
  #undef DMA_K
  #undef DMA_V
  #undef CMASK
  #undef START
  #undef RESC
  #undef ROT
}
constexpr int ATTN_LDS_BYTES=LDS_BYTES;
#undef SBAR
#undef WAIT_BAR
}
constexpr int NWAVES = 8;
constexpr int DM = 1024, LP = 2048, LS = 8192, NBP = 16, NBS = 8;
constexpr int TOKP = NBP * LP, TOKS = NBS * LS, TT = TOKP + TOKS;
constexpr int HYW = 512, INC = 2304, DFF = 2816, QW = 512;
constexpr float EPS = 1e-6f;
constexpr float QSCALE = 0.125f * 1.4426950408889634f;
constexpr size_t MiB = 1u << 20;
constexpr size_t WS_CTL = 0, CTL_ZERO_BYTES = 1 * MiB;
constexpr size_t WS_ROWSQ1 = 0, WS_ROWSQ2 = 512 * 1024, WS_BAR = 900 * 1024, WS_QCTR = 1000 * 1024;
constexpr size_t WS_WIN = 2 * MiB, WS_WOUT = 7 * MiB, WS_WGU = 9 * MiB, WS_WD = 20 * MiB;
constexpr size_t WS_HRAW = 26 * MiB;
constexpr size_t WS_TAB = 66 * MiB;
constexpr size_t WS_A = 128 * MiB;
constexpr size_t WS_YT = WS_A, WS_MIX = WS_A + 96 * MiB, WS_O = WS_A + 288 * MiB;
constexpr size_t WS_B = 656 * MiB;
constexpr size_t WS_ZT = WS_B, WS_X0T = WS_B + 96 * MiB;
constexpr size_t WS_Q = 848 * MiB;
constexpr size_t WS_K = 944 * MiB, WS_V = 968 * MiB;
constexpr size_t WS_END = 992 * MiB;
static_assert(WS_WIN + (size_t)INC * DM * 2 <= WS_WOUT && WS_WGU + (size_t)2 * DFF * DM * 2 <= WS_WD && WS_WD + (size_t)DM * DFF * 2 <= WS_HRAW, "weights map");
static_assert(WS_A + (size_t)TT * DFF * 2 <= WS_B && WS_A + (size_t)TT * INC * 2 <= WS_B && WS_B + (size_t)TT * DM * 2 <= WS_Q && WS_Q + (size_t)TT * QW * 2 <= WS_K, "activation map");
constexpr int RING_BYTES = 131072;
constexpr int LDSCTL_OFF = RING_BYTES, ZERO_OFF = LDSCTL_OFF + 64;
constexpr int LDS_BYTES = 147456, BARST_OFF = LDS_BYTES - 64;

#define GAS __attribute__((address_space(1)))
#define LAS __attribute__((address_space(3)))
typedef unsigned short bf16;
typedef unsigned v4u __attribute__((ext_vector_type(4)));
typedef unsigned v2u __attribute__((ext_vector_type(2)));
typedef float f32x4 __attribute__((ext_vector_type(4)));
typedef float f32x16 __attribute__((ext_vector_type(16)));
typedef short s16x8 __attribute__((ext_vector_type(8)));
#define LDS_WAIT() asm volatile("s_waitcnt lgkmcnt(0)" ::: "memory")
__device__ __forceinline__ unsigned f2bf(float f) { unsigned u = __builtin_bit_cast(unsigned, f); return (u + 0x7fffu + ((u >> 16) & 1u)) >> 16; }
__device__ __forceinline__ unsigned pk2(float lo, float hi) { return f2bf(lo) | (f2bf(hi) << 16); }
__device__ __forceinline__ float bflo(unsigned w) { return __builtin_bit_cast(float, w << 16); }
__device__ __forceinline__ float bfhi(unsigned w) { return __builtin_bit_cast(float, w & 0xffff0000u); }
__device__ __forceinline__ float wave_sum(float v) {
#pragma unroll
    for (int o = 1; o < 64; o <<= 1) v += __shfl_xor(v, o);
    return v;
}
__device__ __forceinline__ float half_sum(float v) {
#pragma unroll
    for (int o = 1; o < 32; o <<= 1) v += __shfl_xor(v, o);
    return v;
}
__device__ __forceinline__ float rdlane(float v, int l) { return __builtin_bit_cast(float, __builtin_amdgcn_readlane(__builtin_bit_cast(int, v), l)); }
template <int CTRL> __device__ __forceinline__ float dpp_f(float v) { return __builtin_bit_cast(float, __builtin_amdgcn_update_dpp(0, __builtin_bit_cast(int, v), CTRL, 0xF, 0xF, true)); }
__device__ __forceinline__ float oct_sum(float v) { v += dpp_f<0xB1>(v); v += dpp_f<0x4E>(v); v += dpp_f<0x141>(v); return v; }
__device__ __forceinline__ float sin_rev(float rev) { return __builtin_amdgcn_sinf(__builtin_amdgcn_fractf(rev)); }
__device__ __forceinline__ float cos_rev(float rev) { return __builtin_amdgcn_cosf(__builtin_amdgcn_fractf(rev)); }
__device__ __forceinline__ float sin_rad(float x) { return sin_rev(x * 0.15915494309189535f); }

#define XB_TMO      128
#define XB_XCNT(j)  (256  + 64 * (j))
#define XB_XSUB(j)  (1280 + 64 * (j))
#define XB_XGEN(j)  (2304 + 64 * (j))
#define XB_TOP      3328
#define XB_TOPGEN   3392
#define XCD_BAR_WORDS 3456
#define XB_SPIN_CAP (1u << 18)

__device__ __forceinline__ unsigned xb_ld(unsigned* p)              { return __hip_atomic_load(p, __ATOMIC_RELAXED, __HIP_MEMORY_SCOPE_AGENT); }
__device__ __forceinline__ unsigned xb_add(unsigned* p, unsigned v) { return __hip_atomic_fetch_add(p, v, __ATOMIC_RELAXED, __HIP_MEMORY_SCOPE_AGENT); }
__device__ __forceinline__ unsigned xb_xcc_id() { return (unsigned)__builtin_amdgcn_s_getreg((3 << 11) | 20) & 0xFu; }
#define XB_SPIN(cond, bar) do { unsigned _sp = 0; while (cond) { __builtin_amdgcn_s_sleep(1); \
    if ((++_sp & 255u) == 0u) { if (xb_ld(&(bar)[XB_TMO])) break; if (_sp > XB_SPIN_CAP) { atomicAdd(&(bar)[XB_TMO], 1u); break; } } } } while (0)

struct XcdBarrier {
    unsigned* bar; unsigned x;
    volatile LAS unsigned* st;
};

__device__ __forceinline__ XcdBarrier xcd_barrier_post(unsigned* bar, volatile LAS unsigned* st) {
    XcdBarrier b; b.bar = bar; b.x = xb_xcc_id(); b.st = st;
    if (threadIdx.x == 0) (void)xb_add(&bar[XB_XCNT(b.x)], 1u);
    return b;
}
__device__ __forceinline__ void xcd_barrier_complete(unsigned* bar, unsigned x, unsigned& nloc, unsigned& nx) {
    const unsigned G = gridDim.x * gridDim.y * gridDim.z;
    unsigned sum, cnt, mine, sp = 0u;
    for (;;) {
        sum = 0u; cnt = 0u; mine = 0u;
#pragma unroll
        for (unsigned j = 0; j < 16; ++j) { const unsigned c = xb_ld(&bar[XB_XCNT(j)]); sum += c; cnt += (c > 0u) ? 1u : 0u; mine = (j == x) ? c : mine; }
        if (sum == G) break;
        __builtin_amdgcn_s_sleep(1);
        if ((++sp & 255u) == 0u) { if (xb_ld(&bar[XB_TMO])) break; if (sp > XB_SPIN_CAP) { atomicAdd(&bar[XB_TMO], 1u); break; } }
    }
    nloc = mine > 0u ? mine : 1u; nx = cnt > 0u ? cnt : 1u;
}

__device__ __forceinline__ void xcd_barrier(const XcdBarrier& b) {
    asm volatile("s_waitcnt vmcnt(0)" ::: "memory");
    __syncthreads();
    if (threadIdx.x == 0) {
        unsigned* bar = b.bar;
        __builtin_amdgcn_s_waitcnt(0);
        unsigned nloc = b.st[0], nx = b.st[1];
        if (nloc == 0u) { xcd_barrier_complete(bar, b.x, nloc, nx); b.st[0] = nloc; b.st[1] = nx; }
        const unsigned old = xb_add(&bar[XB_XSUB(b.x)], 1u);
        const unsigned gen = old / nloc;
        if (old + 1u == (gen + 1u) * nloc) {
            __builtin_amdgcn_fence(__ATOMIC_RELEASE, "agent");
            asm volatile("s_waitcnt vmcnt(0)" ::: "memory");
            const unsigned og = xb_add(&bar[XB_TOP], 1u);
            const unsigned tg = og / nx;
            if (og + 1u == (tg + 1u) * nx) xb_add(&bar[XB_TOPGEN], 1u);
            else XB_SPIN(xb_ld(&bar[XB_TOPGEN]) == tg, bar);
            __builtin_amdgcn_fence(__ATOMIC_ACQUIRE, "agent");
            xb_add(&bar[XB_XGEN(b.x)], 1u);
            asm volatile("s_waitcnt vmcnt(0)" ::: "memory");
        } else {
            XB_SPIN(xb_ld(&bar[XB_XGEN(b.x)]) == gen, bar);
            __builtin_amdgcn_fence(__ATOMIC_ACQUIRE, "agent");
            asm volatile("s_waitcnt vmcnt(0)" ::: "memory");
        }
    }
    __syncthreads();
}

typedef const float* cfp;
struct Frame {
    LAS unsigned char* lds;
    int tid, lane, wave, vcu, G;
    const __attribute__((address_space(4))) cfp* in;
    float* out; unsigned char* ws;
};

__device__ __forceinline__ void p0_transpose_item(const float* W, int K, int N, bf16* WT, int mode, const float* kscale, LAS float* scr, int item, int lane) {
    const int nblk = N / 32, kb = item / nblk, nb = item % nblk, k0 = 64 * kb, n0 = 32 * nb;
#pragma unroll 8
    for (int i = 0; i < 32; ++i) { const int kk = 2 * i + (lane >> 5); float v = W[(size_t)(k0 + kk) * N + n0 + (lane & 31)]; if (kscale) v *= kscale[k0 + kk]; scr[kk * 33 + (lane & 31)] = v; }
    LDS_WAIT(); asm volatile("" ::: "memory");
    const int c = lane & 7;
    const int rbase = (mode == 0) ? n0 : ((n0 >> 7) * 256 + (n0 & 127) + (mode == 2 ? 128 : 0));
#pragma unroll
    for (int j = 0; j < 4; ++j) { const int n = (lane >> 3) + 8 * j; const LAS float* s = scr + (8 * c) * 33 + n;
        v4u o; o.x = pk2(s[0 * 33], s[1 * 33]); o.y = pk2(s[2 * 33], s[3 * 33]); o.z = pk2(s[4 * 33], s[5 * 33]); o.w = pk2(s[6 * 33], s[7 * 33]);
        *(GAS v4u*)(WT + (size_t)(rbase + n) * K + k0 + 8 * c) = o; }
    LDS_WAIT(); asm volatile("" ::: "memory");
}
__device__ __forceinline__ void rms_rows4_to_bf16(const float* xrow, const float* g, bf16* orow, int lane) {
    f32x4 v[4][4]; float s[4];
#pragma unroll
    for (int i = 0; i < 4; ++i) { const GAS f32x4* xr = (const GAS f32x4*)(xrow + (size_t)i * DM) + lane; s[i] = 0.f;
#pragma unroll
        for (int j = 0; j < 4; ++j) v[i][j] = xr[64 * j]; }
#pragma unroll
    for (int i = 0; i < 4; ++i) {
#pragma unroll
        for (int j = 0; j < 4; ++j) s[i] += (v[i][j].x * v[i][j].x + v[i][j].y * v[i][j].y) + (v[i][j].z * v[i][j].z + v[i][j].w * v[i][j].w);
        s[i] = 1.0f / sqrtf(wave_sum(s[i]) * (1.f / DM) + EPS); }
    const GAS f32x4* gr = (const GAS f32x4*)g + lane;
#pragma unroll
    for (int j = 0; j < 4; ++j) { const f32x4 gg = gr[64 * j];
#pragma unroll
        for (int i = 0; i < 4; ++i) { GAS unsigned long long* o8 = (GAS unsigned long long*)(orow + (size_t)i * DM) + lane; const float rs = s[i];
            o8[64 * j] = (unsigned long long)pk2(v[i][j].x * rs * gg.x, v[i][j].y * rs * gg.y) | ((unsigned long long)pk2(v[i][j].z * rs * gg.z, v[i][j].w * rs * gg.w) << 32); } }
}
__device__ __forceinline__ void p0_filter_group(const Frame& F, int grp) {
    const int seg = grp < (LP / 8) ? 0 : 1, L = seg ? LS : LP, t0 = (seg ? grp - LP / 8 : grp) * 8, lane = F.lane;
    float* hraw = (float*)(F.ws + WS_HRAW) + (seg ? (size_t)1024 * LP : 0);
    const float fr = F.in[11][lane], b1 = F.in[7][lane], b2 = F.in[9][lane];
    const float invL = 1.0f / (float)L, invLm1 = 1.0f / (float)(L - 1);
    float h2[8];
    {
        float pre[8], h1[8];
        const float w10 = F.in[6][lane];
#pragma unroll
        for (int ti = 0; ti < 8; ++ti) pre[ti] = b1 + ((float)(t0 + ti) * invLm1) * w10;
#pragma unroll 4
        for (int j = 0; j < 16; ++j) {
            const float wc = F.in[6][(1 + j) * 64 + lane], wsn = F.in[6][(17 + j) * 64 + lane];
            const float bandL = (1e-4f + (float)j * ((15.0f - 1e-4f) / 15.0f)) * invL;
#pragma unroll
            for (int ti = 0; ti < 8; ++ti) { const float rev = (float)(t0 + ti) * bandL; pre[ti] += cos_rev(rev) * wc - sin_rev(rev) * wsn; }
        }
#pragma unroll
        for (int ti = 0; ti < 8; ++ti) { h1[ti] = sin_rad(fr * pre[ti]); pre[ti] = b2; }
#pragma unroll 8
        for (int k = 0; k < 64; ++k) {
            const float w = F.in[8][k * 64 + lane];
#pragma unroll
            for (int ti = 0; ti < 8; ++ti) pre[ti] += rdlane(h1[ti], k) * w;
        }
#pragma unroll
        for (int ti = 0; ti < 8; ++ti) h2[ti] = sin_rad(fr * pre[ti]);
    }
    {
        float acc[8][16];
#pragma unroll
        for (int ti = 0; ti < 8; ++ti)
#pragma unroll
            for (int q = 0; q < 16; ++q) acc[ti][q] = 0.f;
#pragma unroll 2
        for (int k = 0; k < 64; ++k) {
            const GAS f32x4* wr = (const GAS f32x4*)(F.in[10] + (size_t)k * 1024 + lane * 16);
            const f32x4 w0 = wr[0], w1 = wr[1], w2 = wr[2], w3 = wr[3];
#pragma unroll
            for (int ti = 0; ti < 8; ++ti) { const float hv = rdlane(h2[ti], k);
#pragma unroll
                for (int q = 0; q < 4; ++q) { acc[ti][q] += hv * w0[q]; acc[ti][4 + q] += hv * w1[q]; acc[ti][8 + q] += hv * w2[q]; acc[ti][12 + q] += hv * w3[q]; } }
        }
#pragma unroll
        for (int q = 0; q < 16; ++q) {
            const int o = lane * 16 + q;
            const float dec = fabsf(F.in[12][o]) * 1.4426950408889634f;
            f32x4 v0, v1;
#pragma unroll
            for (int ti = 0; ti < 4; ++ti) { v0[ti] = acc[ti][q] * __builtin_amdgcn_exp2f(-((float)(t0 + ti) * invLm1) * dec); v1[ti] = acc[4 + ti][q] * __builtin_amdgcn_exp2f(-((float)(t0 + 4 + ti) * invLm1) * dec); }
            GAS f32x4* dst = (GAS f32x4*)(hraw + (size_t)o * L + t0);
            dst[0] = v0; dst[1] = v1;
        }
    }
}
__device__ __forceinline__ void p0_prologue(const Frame& F) {
    LAS float* scr = (LAS float*)(F.lds + F.wave * 16384);
    const int gw = F.vcu * NWAVES + F.wave, NGW = F.G * NWAVES;
    bf16* Win_t = (bf16*)(F.ws + WS_WIN); bf16* Wout_t = (bf16*)(F.ws + WS_WOUT); bf16* Wgu_t = (bf16*)(F.ws + WS_WGU); bf16* Wd_t = (bf16*)(F.ws + WS_WD);
    constexpr int I_IN = (DM / 64) * (INC / 32), I_OUT = (DM / 64) * (DM / 32), I_G = (DM / 64) * (DFF / 32), I_D = (DFF / 64) * (DM / 32);
    constexpr int NITEMS = I_IN + I_OUT + 2 * I_G + I_D;
    if (F.wave < 5) for (int g = F.vcu * 5 + F.wave; g < (LP + LS) / 8; g += F.G * 5) p0_filter_group(F, g);
    for (int it = gw; it < NITEMS; it += NGW) {
        int r = it;
        if (r < I_IN) { p0_transpose_item(F.in[3], DM, INC, Win_t, 0, nullptr, scr, r, F.lane); continue; } r -= I_IN;
        if (r < I_OUT) { p0_transpose_item(F.in[18], DM, DM, Wout_t, 0, nullptr, scr, r, F.lane); continue; } r -= I_OUT;
        if (r < I_G) { p0_transpose_item(F.in[20], DM, DFF, Wgu_t, 1, F.in[19], scr, r, F.lane); continue; } r -= I_G;
        if (r < I_G) { p0_transpose_item(F.in[21], DM, DFF, Wgu_t, 2, F.in[19], scr, r, F.lane); continue; } r -= I_G;
        p0_transpose_item(F.in[22], DFF, DM, Wd_t, 0, nullptr, scr, r, F.lane);
    }
    bf16* hb = (bf16*)(F.ws + WS_B);
    for (int m = gw * 4; m < TT; m += NGW * 4) rms_rows4_to_bf16(m < TOKP ? F.in[0] + (size_t)m * DM : F.in[1] + (size_t)(m - TOKP) * DM, F.in[2], hb + (size_t)m * DM, F.lane);
}
__device__ __forceinline__ void seq_of(int m, int& s0, int& L) { if (m < TOKP) { L = LP; s0 = m & ~(LP - 1); } else { L = LS; s0 = TOKP + ((m - TOKP) & ~(LS - 1)); } }
__device__ __forceinline__ void p2_conv_task(const Frame& F, int tt, int cgp) {
    const bf16* proj = (const bf16*)(F.ws + WS_A); bf16* zT = (bf16*)(F.ws + WS_ZT); bf16* x0T = (bf16*)(F.ws + WS_X0T);
    const int m0 = tt * 64; int s0, L; seq_of(m0, s0, L);
    const int cp = F.lane & 31, th = F.lane >> 5, c = cgp * 64 + 2 * cp, tl0 = m0 - s0 + 32 * th;
    float w[3][3][2], bs[3][2];
#pragma unroll
    for (int g = 0; g < 3; ++g)
#pragma unroll
        for (int k = 0; k < 2; ++k) { bs[g][k] = F.in[5][g * 512 + c + k];
#pragma unroll
            for (int j = 0; j < 3; ++j) w[g][j][k] = F.in[4][j * 1536 + g * 512 + c + k]; }
    unsigned zA[16], zB[16], xA[16], xB[16];
#pragma unroll
    for (int hh = 0; hh < 2; ++hh) {
        unsigned uu[18][3];
#pragma unroll
        for (int r = 0; r < 18; ++r) { const int t = tl0 + 16 * hh + r - 1; const int tcl = t < 0 ? 0 : (t >= L ? L - 1 : t); const bf16* p = proj + (size_t)(s0 + tcl) * INC + c;
            const bool ok = (t >= 0) && (t < L); const unsigned a0 = *(const unsigned*)p, a1 = *(const unsigned*)(p + 512), a2 = *(const unsigned*)(p + 1024);
            uu[r][0] = ok ? a0 : 0u; uu[r][1] = ok ? a1 : 0u; uu[r][2] = ok ? a2 : 0u; }
#pragma unroll
        for (int r = 0; r < 16; ++r) {
            float uc[3][2];
#pragma unroll
            for (int g = 0; g < 3; ++g) {
                uc[g][0] = bs[g][0] + w[g][0][0] * bflo(uu[r][g]) + w[g][1][0] * bflo(uu[r + 1][g]) + w[g][2][0] * bflo(uu[r + 2][g]);
                uc[g][1] = bs[g][1] + w[g][0][1] * bfhi(uu[r][g]) + w[g][1][1] * bfhi(uu[r + 1][g]) + w[g][2][1] * bfhi(uu[r + 2][g]);
            }
            const unsigned za = f2bf(uc[1][0] * uc[2][0]), zb = f2bf(uc[1][1] * uc[2][1]), xa = f2bf(uc[0][0]), xb = f2bf(uc[0][1]);
            const int q = 8 * hh + (r >> 1);
            if (r & 1) { zA[q] |= za << 16; zB[q] |= zb << 16; xA[q] |= xa << 16; xB[q] |= xb << 16; }
            else { zA[q] = za; zB[q] = zb; xA[q] = xa; xB[q] = xb; }
        }
    }
    const size_t o = (size_t)s0 * 512 + (size_t)c * L + tl0;
#pragma unroll
    for (int i = 0; i < 4; ++i) {
        *(GAS v4u*)(zT + o + 8 * i) = (v4u){zA[4 * i], zA[4 * i + 1], zA[4 * i + 2], zA[4 * i + 3]};
        *(GAS v4u*)(zT + o + L + 8 * i) = (v4u){zB[4 * i], zB[4 * i + 1], zB[4 * i + 2], zB[4 * i + 3]};
        *(GAS v4u*)(x0T + o + 8 * i) = (v4u){xA[4 * i], xA[4 * i + 1], xA[4 * i + 2], xA[4 * i + 3]};
        *(GAS v4u*)(x0T + o + L + 8 * i) = (v4u){xB[4 * i], xB[4 * i + 1], xB[4 * i + 2], xB[4 * i + 3]};
    }
}
__device__ __forceinline__ void p2_qkv_task(const Frame& F, int tt) {
    const bf16* proj = (const bf16*)(F.ws + WS_A); bf16* qn = (bf16*)(F.ws + WS_Q); bf16* kn = (bf16*)(F.ws + WS_K); bf16* vb = (bf16*)(F.ws + WS_V);
    const int i8 = F.lane & 7, tk = F.lane >> 3;
    float inv[4];
#pragma unroll
    for (int q = 0; q < 4; ++q) inv[q] = __builtin_amdgcn_exp2f(-(float)((4 * i8 + q) & 15) * (13.287712379549449f / 16.0f)) * 0.15915494309189535f;
    const f32x4 gq0 = *(const GAS f32x4*)(F.in[14] + 8 * i8), gq1 = *(const GAS f32x4*)(F.in[14] + 8 * i8 + 4), gk0 = *(const GAS f32x4*)(F.in[15] + 8 * i8), gk1 = *(const GAS f32x4*)(F.in[15] + 8 * i8 + 4);
#pragma unroll 1
    for (int it = 0; it < 4; ++it) {
        const int m = tt * 32 + 8 * it + tk; int s0, L; seq_of(m, s0, L);
        const int t = m - s0; const float pos = (float)((i8 < 4) ? (t >> 6) : (t & 63));
        const bf16* row = proj + (size_t)m * INC;
        v4u hv[10], vv[2];
#pragma unroll
        for (int h = 0; h < 10; ++h) hv[h] = *(const GAS v4u*)(row + 1536 + h * 64 + 8 * i8);
#pragma unroll
        for (int h = 0; h < 2; ++h) vv[h] = *(const GAS v4u*)(row + 2176 + h * 64 + 8 * i8);
        float cs[4], sn[4];
#pragma unroll
        for (int q = 0; q < 4; ++q) { const float rev = pos * inv[q]; cs[q] = cos_rev(rev); sn[q] = sin_rev(rev); }
#pragma unroll
        for (int h = 0; h < 10; ++h) {
            float f[8] = {bflo(hv[h].x), bfhi(hv[h].x), bflo(hv[h].y), bfhi(hv[h].y), bflo(hv[h].z), bfhi(hv[h].z), bflo(hv[h].w), bfhi(hv[h].w)};
            float ss = 0.f;
#pragma unroll
            for (int q = 0; q < 8; ++q) ss += f[q] * f[q];
            const float rstd = (1.0f / sqrtf(oct_sum(ss) * (1.0f / 64.0f) + EPS)) * (h < 8 ? QSCALE : 1.0f);
            const f32x4 g0 = h < 8 ? gq0 : gk0, g1 = h < 8 ? gq1 : gk1;
            f[0] *= rstd * g0.x; f[1] *= rstd * g0.y; f[2] *= rstd * g0.z; f[3] *= rstd * g0.w; f[4] *= rstd * g1.x; f[5] *= rstd * g1.y; f[6] *= rstd * g1.z; f[7] *= rstd * g1.w;
            unsigned w[4];
#pragma unroll
            for (int q = 0; q < 4; ++q) w[q] = pk2(f[2 * q] * cs[q] - f[2 * q + 1] * sn[q], f[2 * q] * sn[q] + f[2 * q + 1] * cs[q]);
            if (h < 8) *(GAS v4u*)(qn + (size_t)m * QW + h * 64 + 8 * i8) = (v4u){w[0], w[1], w[2], w[3]};
            else *(GAS v4u*)(kn + ((size_t)(h - 8) * TT + m) * 64 + 8 * i8) = (v4u){w[0], w[1], w[2], w[3]};
        }
#pragma unroll
        for (int h = 0; h < 2; ++h) *(GAS v4u*)(vb + ((size_t)h * TT + m) * 64 + 8 * i8) = vv[h];
    }
}
__device__ __forceinline__ void p2_table_task(const Frame& F, int id) {
    const int seg = id >> 9, c = id & 511, L = seg ? LS : LP, lane = F.lane;
    const float* hraw = (const float*)(F.ws + WS_HRAW) + (seg ? (size_t)1024 * LP : 0);
    const float* hf = hraw + (size_t)c * L; const float* hbk = hraw + (size_t)(512 + c) * L;
    float s = 0.f;
#pragma unroll 8
    for (int i = lane * 4; i < L; i += 256) { const f32x4 a = *(const GAS f32x4*)(hf + i), b = *(const GAS f32x4*)(hbk + i);
        s += (fabsf(a.x) + fabsf(a.y)) + (fabsf(a.z) + fabsf(a.w)) + (i == 0 ? 0.f : fabsf(b.x)) + fabsf(b.y) + (fabsf(b.z) + fabsf(b.w)); }
    const float inv = 1.0f / wave_sum(s);
    bf16* T0 = (bf16*)(F.ws + WS_TAB) + (seg ? (size_t)512 * 2 * 2 * LP : 0) + (size_t)c * 4 * L; bf16* T1 = T0 + 2 * L;
    const int boff = 512 * L - L;
#pragma unroll 4
    for (int x0 = lane * 8; x0 < 2 * L; x0 += 512) {
        float v[9];
#pragma unroll
        for (int j = 0; j < 9; ++j) { const int x = x0 + j; const int xi = x >= 2 * L ? 2 * L - 1 : x; const float t = hf[xi <= L ? L - xi : boff + xi]; v[j] = (x == 0 || x >= 2 * L) ? 0.f : t * inv; }
        *(GAS v4u*)(T0 + x0) = (v4u){pk2(v[0], v[1]), pk2(v[2], v[3]), pk2(v[4], v[5]), pk2(v[6], v[7])};
        *(GAS v4u*)(T1 + x0) = (v4u){pk2(v[1], v[2]), pk2(v[3], v[4]), pk2(v[5], v[6]), pk2(v[7], v[8])};
    }
}
__device__ __forceinline__ void p2_phase(const Frame& F) {
    const int gw = F.vcu * NWAVES + F.wave, NGW = F.G * NWAVES;
    constexpr int N_CONV = (TT / 64) * 8, N_QKV = TT / 32, N_TAB = 0;
    for (int id = gw; id < N_CONV + N_QKV + N_TAB; id += NGW) {
        if (id < N_CONV) p2_conv_task(F, id >> 3, id & 7);
        else if (id < N_CONV + N_QKV) p2_qkv_task(F, id - N_CONV);
        else p2_table_task(F, id - N_CONV - N_QKV);
    }
}
typedef unsigned v4u_a4 __attribute__((ext_vector_type(4), aligned(4)));
template <int NB> __device__ __forceinline__ int zaddr(int tc, int b) { return NB == 16 ? 256 * tc + 16 * b : 128 * tc + 16 * b; }
template <int TPW, int CB, int ZTOP, bool CLAMP>
__device__ __forceinline__ void hy_groups(int g0, int g1, LAS unsigned char* lds, f32x16 (&acc)[TPW], v4u (&a)[4], v4u (&bx)[TPW / 2], v4u (&by)[TPW / 2], int (&off)[4], const char*& pa, bool next_clamped) {
    constexpr int HT = TPW / 2;
#define HY_RD(dst, base, h, CL) do { _Pragma("unroll") for (int jj = 0; jj < HT; ++jj) { int ad = (base) + ((h) * HT + jj) * 2048; if (CL) ad = ad < 0 ? 0 : (ad > ZTOP ? ZTOP : ad); dst[jj] = *(const LAS v4u*)(lds + ad); } } while (0)
#define HY_MM(av, src, h) do { _Pragma("unroll") for (int jj = 0; jj < HT; ++jj) acc[(h) * HT + jj] = __builtin_amdgcn_mfma_f32_32x32x16_bf16(__builtin_bit_cast(s16x8, av), __builtin_bit_cast(s16x8, src[jj]), acc[(h) * HT + jj], 0, 0, 0); } while (0)
#define HY_SB() __builtin_amdgcn_sched_barrier(0)
    for (int g = g0; g < g1; ++g) {
        v4u an[4];
#pragma unroll
        for (int u = 0; u < 4; ++u) an[u] = *(const GAS v4u_a4*)(pa - 32 * u);
        pa -= 128;
        HY_SB();
        HY_RD(by, off[0], 1, CLAMP); HY_SB(); HY_MM(a[0], bx, 0); HY_SB(); HY_RD(bx, off[1], 0, CLAMP); HY_SB(); HY_MM(a[0], by, 1); HY_SB();
        HY_RD(by, off[1], 1, CLAMP); HY_SB(); HY_MM(a[1], bx, 0); HY_SB(); HY_RD(bx, off[2], 0, CLAMP); HY_SB(); HY_MM(a[1], by, 1); HY_SB();
        HY_RD(by, off[2], 1, CLAMP); HY_SB(); HY_MM(a[2], bx, 0); HY_SB(); HY_RD(bx, off[3], 0, CLAMP); HY_SB(); HY_MM(a[2], by, 1); HY_SB();
        HY_RD(by, off[3], 1, CLAMP); HY_SB(); HY_MM(a[3], bx, 0); HY_SB();
#pragma unroll
        for (int u = 0; u < 4; ++u) off[u] -= 8 * CB;
        if (CLAMP || (next_clamped && g + 1 == g1)) HY_RD(bx, off[0], 0, true); else HY_RD(bx, off[0], 0, false);
        HY_SB(); HY_MM(a[3], by, 1); HY_SB();
#pragma unroll
        for (int u = 0; u < 4; ++u) a[u] = an[u];
    }
#undef HY_RD
#undef HY_MM
#undef HY_SB
}
template <int NB, int L> __device__ __forceinline__ void hyena_unit(const Frame& F, int c) {
    constexpr bool SEG = (L == LS);
    constexpr int TPB = 32 / NB, NTILES = NB * (L / 32) / 32, TPW = NTILES / NWAVES, CH = L / 8, CB = NB * 16, ZB = 4096, ZIMG = NB * L * 2;
    constexpr int NSTEP = L / 16 + 2 * (TPW * TPB - 1), NG = (NSTEP + 3) / 4;
    static_assert(ZB + ZIMG + ZB <= RING_BYTES + 12288, "Z image + pads fit the LDS allocation");
    const size_t zbase = (SEG ? (size_t)TOKP * 512 : 0) + (size_t)c * L;
    const bf16* zT = (const bf16*)(F.ws + WS_ZT) + zbase; const bf16* x0T = (const bf16*)(F.ws + WS_X0T) + zbase; bf16* yT = (bf16*)(F.ws + WS_YT) + zbase;
    const bf16* T0 = (const bf16*)(F.ws + WS_TAB) + (SEG ? (size_t)512 * 2 * 2 * LP : 0) + (size_t)c * 4 * L; const bf16* T1 = T0 + 2 * L;
    LAS unsigned char* lds = F.lds;
    __syncthreads();
    for (int q = F.tid; q < 2 * ZB / 16; q += NWAVES * 64) *(LAS v4u*)(lds + (q < ZB / 16 ? q * 16 : ZIMG + q * 16)) = (v4u){0u, 0u, 0u, 0u};
    { v4u wsum = (v4u){0u, 0u, 0u, 0u};
#pragma unroll
      for (int i = 0; i < (8 * L) / (16 * NWAVES * 64); ++i) { const v4u v = *(const GAS v4u*)((const char*)T0 + (size_t)(i * NWAVES * 64 + F.tid) * 16); wsum.x |= v.x; wsum.y |= v.y; wsum.z |= v.z; wsum.w |= v.w; }
      asm volatile("" :: "v"(wsum)); }
    for (int q = F.tid; q < NB * CH; q += NWAVES * 64) { const int b = q / CH, tc = q % CH; const v4u v = *(const GAS v4u*)(zT + (size_t)b * 512 * L + tc * 8); *(LAS v4u*)(lds + ZB + zaddr<NB>(tc, b)) = v; }
    __syncthreads();
    const int lane = F.lane, n = lane & 31, kg = lane >> 5, bn = n % NB, t1o = n / NB;
    const int t1_lo = F.wave * TPW * TPB, e_max = 2 * (t1_lo + TPW * TPB - 1), e0 = e_max - 4 * NG + 1;
    const int tcg0 = 4 * (t1_lo + t1o) - 2 * e0 + kg;
    int off[4];
#pragma unroll
    for (int u = 0; u < 4; ++u) off[u] = ZB + zaddr<NB>(tcg0 - 2 * u, bn);
    const char* pa = (const char*)(((n & 1) ? T1 - 1 : T0) + (L - n + 8 * kg)) - 32 * (long)e0;
    f32x16 acc[TPW];
#pragma unroll
    for (int jj = 0; jj < TPW; ++jj) acc[jj] = f32x16{};
    v4u a[4];
#pragma unroll
    for (int u = 0; u < 4; ++u) a[u] = *(const GAS v4u_a4*)(pa - 32 * u);
    pa -= 128;
    constexpr int ZTOP = ZB + ZIMG + ZB - 16, HT = TPW / 2;
    const int t1_hi = t1_lo + TPW * TPB - 1;
    int gA = (2 * t1_hi + 1 - (CH - 1) / 2 - e0 + 3) >> 2; gA = gA < 0 ? 0 : gA;
    int gB = ((2 * t1_lo - 3 - e0) >> 2) + 1; gB = gB > NG ? NG : gB; if (gB < gA) gB = gA;
    v4u bx[HT], by[HT];
    { int ad0[HT];
#pragma unroll
      for (int jj = 0; jj < HT; ++jj) { int ad = off[0] + jj * 2048; ad0[jj] = ad < 0 ? 0 : (ad > ZTOP ? ZTOP : ad); bx[jj] = *(const LAS v4u*)(lds + ad0[jj]); } }
    hy_groups<TPW, CB, ZTOP, true>(0, gA, lds, acc, a, bx, by, off, pa, false);
    hy_groups<TPW, CB, ZTOP, false>(gA, gB, lds, acc, a, bx, by, off, pa, true);
    hy_groups<TPW, CB, ZTOP, true>(gB, NG, lds, acc, a, bx, by, off, pa, false);
    const float dc = F.in[13][c];
    int n2 = n, kg2 = kg; asm volatile("" : "+v"(n2), "+v"(kg2));
    const int bn2 = n2 % NB, t1o2 = n2 / NB;
#pragma unroll
    for (int jj = 0; jj < TPW; ++jj) {
        const int t1 = t1_lo + jj * TPB + t1o2;
        const size_t gb = (size_t)bn2 * 512 * L + 32 * t1 + 4 * kg2;
#pragma unroll
        for (int rq = 0; rq < 4; ++rq) {
            const v2u zz = *(const LAS v2u*)(lds + ZB + zaddr<NB>(4 * t1 + rq, bn2) + 8 * kg2);
            const v2u xx = *(const GAS v2u*)(x0T + gb + 8 * rq);
            const float y0 = (acc[jj][4 * rq + 0] + dc * bflo(zz.x)) * bflo(xx.x), y1 = (acc[jj][4 * rq + 1] + dc * bfhi(zz.x)) * bfhi(xx.x);
            const float y2 = (acc[jj][4 * rq + 2] + dc * bflo(zz.y)) * bflo(xx.y), y3 = (acc[jj][4 * rq + 3] + dc * bfhi(zz.y)) * bfhi(xx.y);
            *(GAS v2u*)(yT + gb + 8 * rq) = (v2u){pk2(y0, y1), pk2(y2, y3)};
        }
    }
}
typedef float f32x4_a4 __attribute__((ext_vector_type(4), aligned(4)));
template <int L> __device__ __forceinline__ void hyena_build_table(const Frame& F, int c, int tid, bf16* T0, LAS float* red) {
    constexpr bool SEG = (L == LS);
    const float* hf = (const float*)(F.ws + WS_HRAW) + (SEG ? (size_t)1024 * LP : 0) + (size_t)c * L; const float* hbk = hf + (size_t)512 * L;
    float s = 0.f;
#pragma unroll
    for (int i = 0; i < L / 2048; ++i) { const int t = (tid + i * 512) * 4; const f32x4 a = *(const GAS f32x4*)(hf + t), b = *(const GAS f32x4*)(hbk + t);
        s += (fabsf(a.x) + fabsf(a.y)) + (fabsf(a.z) + fabsf(a.w)) + (t == 0 ? 0.f : fabsf(b.x)) + fabsf(b.y) + (fabsf(b.z) + fabsf(b.w)); }
    s = wave_sum(s);
    if ((tid & 63) == 0) red[tid >> 6] = s;
    __syncthreads();
    float tot = 0.f;
#pragma unroll
    for (int w = 0; w < NWAVES; ++w) tot += red[w];
    const float inv = 1.0f / tot;
    bf16* T1 = T0 + 2 * L;
#pragma unroll
    for (int i = 0; i < L / 2048; ++i) {
        const int x0 = (tid + i * 512) * 8;
        float v[9];
        if (x0 < L) {
            const f32x4 p = *(const GAS f32x4_a4*)(hf + L - x0 - 8), q = *(const GAS f32x4_a4*)(hf + L - x0 - 4); const float r0 = (x0 == 0) ? 0.f : hf[L - x0];
            v[0] = r0; v[1] = q.w; v[2] = q.z; v[3] = q.y; v[4] = q.x; v[5] = p.w; v[6] = p.z; v[7] = p.y; v[8] = p.x;
        } else {
            const int m = x0 - L; const f32x4 p = *(const GAS f32x4*)(hbk + m), q = *(const GAS f32x4*)(hbk + m + 4); const float r8 = (m + 8 >= L) ? 0.f : hbk[m + 8];
            v[0] = (m == 0) ? hf[0] : p.x; v[1] = p.y; v[2] = p.z; v[3] = p.w; v[4] = q.x; v[5] = q.y; v[6] = q.z; v[7] = q.w; v[8] = r8;
        }
#pragma unroll
        for (int j = 0; j < 9; ++j) v[j] *= inv;
        *(GAS v4u*)(T0 + x0) = (v4u){pk2(v[0], v[1]), pk2(v[2], v[3]), pk2(v[4], v[5]), pk2(v[6], v[7])};
        *(GAS v4u*)(T1 + x0) = (v4u){pk2(v[1], v[2]), pk2(v[3], v[4]), pk2(v[5], v[6]), pk2(v[7], v[8])};
    }
}
template <int TPW, int CB, int ZTOP, bool CLAMP, int JLO = 0, int JHI = TPW / 2>
__device__ __forceinline__ void hy2_groups(int g0, int g1, LAS unsigned char* lds, f32x16 (&acc)[TPW], v4u (&a)[6], v4u (&bx)[TPW / 2], v4u (&by)[TPW / 2], int (&off)[4], const char*& pa, bool next_clamped) {
    constexpr int NC = TPW / 2;
#define HY_RD(dst, base, CL) do { _Pragma("unroll") for (int jc = JLO; jc < JHI; ++jc) { int ad = (base) + jc * 4096; if (CL) ad = ad < 0 ? 0 : (ad > ZTOP ? ZTOP : ad); dst[jc] = *(const LAS v4u*)(lds + ad); } } while (0)
#define HY_MM(a0, a1, src) do { _Pragma("unroll") for (int jc = JLO; jc < JHI; ++jc) { \
        acc[2 * jc] = __builtin_amdgcn_mfma_f32_32x32x16_bf16(__builtin_bit_cast(s16x8, a0), __builtin_bit_cast(s16x8, src[jc]), acc[2 * jc], 0, 0, 0); \
        acc[2 * jc + 1] = __builtin_amdgcn_mfma_f32_32x32x16_bf16(__builtin_bit_cast(s16x8, a1), __builtin_bit_cast(s16x8, src[jc]), acc[2 * jc + 1], 0, 0, 0); } } while (0)
#define HY_SB() __builtin_amdgcn_sched_barrier(0)
#define HY_RDALL(dst, base, CL) do { _Pragma("unroll") for (int jc = 0; jc < NC; ++jc) { int ad = (base) + jc * 4096; if (CL) ad = ad < 0 ? 0 : (ad > ZTOP ? ZTOP : ad); dst[jc] = *(const LAS v4u*)(lds + ad); } } while (0)
    for (int g = g0; g < g1; ++g) {
        v4u an[4];
#pragma unroll
        for (int q = 0; q < 4; ++q) an[q] = *(const GAS v4u_a4*)(pa - 32 * q);
        pa -= 128;
        HY_SB();
        HY_RD(by, off[1], CLAMP); HY_SB(); HY_MM(a[0], a[2], bx); HY_SB();
        HY_RD(bx, off[2], CLAMP); HY_SB(); HY_MM(a[1], a[3], by); HY_SB();
        HY_RD(by, off[3], CLAMP); HY_SB(); HY_MM(a[2], a[4], bx); HY_SB();
#pragma unroll
        for (int v = 0; v < 4; ++v) off[v] -= 8 * CB;
        if (CLAMP || (next_clamped && g + 1 == g1)) HY_RDALL(bx, off[0], true); else HY_RDALL(bx, off[0], false);
        HY_SB(); HY_MM(a[3], a[5], by); HY_SB();
        a[0] = a[4]; a[1] = a[5];
#pragma unroll
        for (int q = 0; q < 4; ++q) a[2 + q] = an[q];
    }
#undef HY_RD
#undef HY_MM
#undef HY_SB
#undef HY_RDALL
}
template <int NB, int L> __device__ __forceinline__ void hyena2_unit(const Frame& F, int c) {
    constexpr bool SEG = (L == LS);
    constexpr int TPB = 32 / NB, NTILES = NB * (L / 32) / 32, TPW = NTILES / NWAVES, NC = TPW / 2, CH = L / 8, CB = NB * 16, ZB = 4096, ZIMG = NB * L * 2;
    constexpr int USPAN = NC * TPB;
    constexpr int NSTEP = L / 16 + 4 * (USPAN - 1), NG = NSTEP / 4;
    static_assert(NSTEP % 4 == 0 && ZB + ZIMG + ZB <= LDS_BYTES - 64, "hyena2 geometry");
    const size_t zbase = (SEG ? (size_t)TOKP * 512 : 0) + (size_t)c * L;
    const bf16* zT = (const bf16*)(F.ws + WS_ZT) + zbase; const bf16* x0T = (const bf16*)(F.ws + WS_X0T) + zbase; bf16* yT = (bf16*)(F.ws + WS_YT) + zbase;
    const bf16* T0 = (const bf16*)(F.ws + WS_TAB) + (SEG ? (size_t)512 * 2 * 2 * LP : 0) + (size_t)c * 4 * L; const bf16* T1 = T0 + 2 * L;
    LAS unsigned char* lds = F.lds;
    int tid = F.tid; asm volatile("" : "+v"(tid));
    __syncthreads();
    hyena_build_table<L>(F, c, tid, (bf16*)T0, (LAS float*)(lds + LDS_BYTES - 256));
    for (int q = tid; q < 2 * ZB / 16; q += NWAVES * 64) *(LAS v4u*)(lds + (q < ZB / 16 ? q * 16 : ZIMG + q * 16)) = (v4u){0u, 0u, 0u, 0u};
    { constexpr int NIT = NB * CH / (NWAVES * 64);
#pragma unroll
      for (int i0 = 0; i0 < NIT; i0 += 8) { v4u v[8];
#pragma unroll
        for (int i = 0; i < 8; ++i) { const int q = tid + (i0 + i) * NWAVES * 64, b = q / CH, tc = q % CH; v[i] = *(const GAS v4u*)(zT + (size_t)b * 512 * L + tc * 8); }
#pragma unroll
        for (int i = 0; i < 8; ++i) { const int q = tid + (i0 + i) * NWAVES * 64, b = q / CH, tc = q % CH; *(LAS v4u*)(lds + ZB + zaddr<NB>(tc, b)) = v[i]; } } }
    asm volatile("s_waitcnt vmcnt(0)" ::: "memory");
    __syncthreads();
    const int lane = tid & 63, n = lane & 31, kg = lane >> 5, bn = n % NB, uo = n / NB;
    const int u_lo = F.wave * USPAN, u_hi = u_lo + USPAN - 1, e0 = 4 * u_lo - L / 16 + 1;
    const int tcg0 = 8 * (u_lo + uo) - 2 * e0 + kg;
    int off[4];
#pragma unroll
    for (int v = 0; v < 4; ++v) off[v] = ZB + zaddr<NB>(tcg0 - 2 * v, bn);
    const char* pa = (const char*)(((n & 1) ? T1 - 1 : T0) + (L - n + 8 * kg)) - 32 * (long)e0;
    f32x16 acc[TPW];
#pragma unroll
    for (int jj = 0; jj < TPW; ++jj) acc[jj] = f32x16{};
    v4u a[6];
#pragma unroll
    for (int q = 0; q < 6; ++q) a[q] = *(const GAS v4u_a4*)(pa - 32 * q);
    pa -= 192;
    constexpr int ZTOP = ZB + ZIMG + ZB - 16;
    int gA = (4 * u_hi + 1 - (CH - 1) / 2 - e0 + 3) >> 2; gA = gA < 0 ? 0 : gA;
    int gB = ((4 * u_lo - 3 - e0) >> 2) + 1; gB = gB > NG ? NG : gB; if (gB < gA) gB = gA;
    v4u bx[NC], by[NC];
#pragma unroll
    for (int jc = 0; jc < NC; ++jc) { int ad = off[0] + jc * 4096; ad = ad < 0 ? 0 : (ad > ZTOP ? ZTOP : ad); bx[jc] = *(const LAS v4u*)(lds + ad); }
    constexpr int G_ALL0 = TPB * (NC - 1), G_ALL1 = L / 64 + TPB - 1;
    static_assert(G_ALL1 + (NC - 1) * TPB == NG && (NC == 4 || NC == 2), "segment map");
    gA = gA < G_ALL0 ? G_ALL0 : gA; gB = gB > G_ALL1 ? G_ALL1 : gB; if (gB < gA) gB = gA;
    if constexpr (NC == 4) {
        hy2_groups<TPW, CB, ZTOP, true, 0, 1>(0, TPB, lds, acc, a, bx, by, off, pa, false);
        hy2_groups<TPW, CB, ZTOP, true, 0, 2>(TPB, 2 * TPB, lds, acc, a, bx, by, off, pa, false);
        hy2_groups<TPW, CB, ZTOP, true, 0, 3>(2 * TPB, 3 * TPB, lds, acc, a, bx, by, off, pa, false);
    } else {
        hy2_groups<TPW, CB, ZTOP, true, 0, 1>(0, TPB, lds, acc, a, bx, by, off, pa, false);
    }
    hy2_groups<TPW, CB, ZTOP, true>(G_ALL0, gA, lds, acc, a, bx, by, off, pa, false);
    hy2_groups<TPW, CB, ZTOP, false>(gA, gB, lds, acc, a, bx, by, off, pa, true);
    hy2_groups<TPW, CB, ZTOP, true>(gB, G_ALL1, lds, acc, a, bx, by, off, pa, false);
    if constexpr (NC == 4) {
        hy2_groups<TPW, CB, ZTOP, true, 1, 4>(G_ALL1, G_ALL1 + TPB, lds, acc, a, bx, by, off, pa, false);
        hy2_groups<TPW, CB, ZTOP, true, 2, 4>(G_ALL1 + TPB, G_ALL1 + 2 * TPB, lds, acc, a, bx, by, off, pa, false);
        hy2_groups<TPW, CB, ZTOP, true, 3, 4>(G_ALL1 + 2 * TPB, NG, lds, acc, a, bx, by, off, pa, false);
    } else {
        hy2_groups<TPW, CB, ZTOP, true, 1, 2>(G_ALL1, NG, lds, acc, a, bx, by, off, pa, false);
    }
    const float dc = F.in[13][c];
    int n2 = n, kg2 = kg; asm volatile("" : "+v"(n2), "+v"(kg2));
    const int bn2 = n2 % NB, uo2 = n2 / NB;
#pragma unroll
    for (int jj = 0; jj < TPW; ++jj) {
        const int t1 = 2 * (u_lo + (jj >> 1) * TPB + uo2) + (jj & 1); const size_t gb = (size_t)bn2 * 512 * L + 32 * t1 + 8 * kg2;
        v4u X[2];
#pragma unroll
        for (int pr = 0; pr < 2; ++pr) X[pr] = *(const GAS v4u*)(x0T + gb + 16 * pr);
#pragma unroll
        for (int pr = 0; pr < 2; ++pr) {
            const unsigned s0 = kg2 ? X[pr].x : X[pr].z, s1 = kg2 ? X[pr].y : X[pr].w;
            const auto r0 = __builtin_amdgcn_permlane32_swap(s0, s0, false, false); const auto r1 = __builtin_amdgcn_permlane32_swap(s1, s1, false, false);
            const unsigned rc0 = kg2 ? r0[0] : r0[1], rc1 = kg2 ? r1[0] : r1[1];
            v2u xq[2];
            xq[0] = kg2 ? (v2u){rc0, rc1} : (v2u){X[pr].x, X[pr].y};
            xq[1] = kg2 ? (v2u){X[pr].z, X[pr].w} : (v2u){rc0, rc1};
            v2u wq[2];
#pragma unroll
            for (int e = 0; e < 2; ++e) { const int rq = 2 * pr + e;
                const v2u zz = *(const LAS v2u*)(lds + ZB + zaddr<NB>(4 * t1 + rq, bn2) + 8 * kg2);
                const float y0 = (acc[jj][4 * rq + 0] + dc * bflo(zz.x)) * bflo(xq[e].x), y1 = (acc[jj][4 * rq + 1] + dc * bfhi(zz.x)) * bfhi(xq[e].x);
                const float y2 = (acc[jj][4 * rq + 2] + dc * bflo(zz.y)) * bflo(xq[e].y), y3 = (acc[jj][4 * rq + 3] + dc * bfhi(zz.y)) * bfhi(xq[e].y);
                wq[e] = (v2u){pk2(y0, y1), pk2(y2, y3)}; }
            const unsigned t0 = kg2 ? wq[0].x : wq[1].x, t1s = kg2 ? wq[0].y : wq[1].y;
            const auto q0 = __builtin_amdgcn_permlane32_swap(t0, t0, false, false); const auto q1 = __builtin_amdgcn_permlane32_swap(t1s, t1s, false, false);
            const unsigned g0 = kg2 ? q0[0] : q0[1], g1 = kg2 ? q1[0] : q1[1];
            const v4u outp = kg2 ? (v4u){g0, g1, wq[1].x, wq[1].y} : (v4u){wq[0].x, wq[0].y, g0, g1};
            *(GAS v4u*)(yT + gb + 16 * pr) = outp;
        }
    }
}
__device__ __forceinline__ void p3_attn(const Frame& F, char* lds_generic) {
    using abf = attn_body::bf16;
    const abf* Q = (const abf*)(F.ws + WS_Q); const abf* K = (const abf*)(F.ws + WS_K); const abf* V = (const abf*)(F.ws + WS_V); abf* O = (abf*)(F.ws + WS_O);
    const int NCU = F.G;
    float gqm = fabsf(F.in[14][F.lane]), gkm = fabsf(F.in[15][F.lane]);
#pragma unroll
    for (int o = 1; o < 64; o <<= 1) { gqm = fmaxf(gqm, __shfl_xor(gqm, o)); gkm = fmaxf(gkm, __shfl_xor(gkm, o)); }
    const float mref = 64.0f * QSCALE * gqm * gkm * 1.02f;
    if (NCU == 256) {
        const int x = F.vcu >> 5, j = F.vcu & 31;
        for (int i = 0; i < 8; ++i) { const int p = 2 * x + (i >> 2), hh = i & 3, b = p >> 1, kvh = p & 1;
            attn_body::attn_unit<8>((long)TOKP + (long)b * LS + (long)j * 256, (long)TOKP + (long)b * LS, LS, kvh * 4 + hh, Q, K, V, O, lds_generic, (long)TT, mref); }
        for (int i = 0; i < 4; ++i) { const int p = 4 * x + i, hh = j >> 3, qb = j & 7, b = p >> 1, kvh = p & 1;
            attn_body::attn_unit<8>((long)b * LP + (long)qb * 256, (long)b * LP, LP, kvh * 4 + hh, Q, K, V, O, lds_generic, (long)TT, mref); }
    } else {
        for (int u = F.vcu; u < 2048; u += NCU) { const int p = u >> 7, hh = (u >> 5) & 3, qb = u & 31, b = p >> 1, kvh = p & 1;
            attn_body::attn_unit<8>((long)TOKP + (long)b * LS + (long)qb * 256, (long)TOKP + (long)b * LS, LS, kvh * 4 + hh, Q, K, V, O, lds_generic, (long)TT, mref); }
        for (int u = F.vcu; u < 1024; u += NCU) { const int p = u >> 5, hh = (u >> 3) & 3, qb = u & 7, b = p >> 1, kvh = p & 1;
            attn_body::attn_unit<8>((long)b * LP + (long)qb * 256, (long)b * LP, LP, kvh * 4 + hh, Q, K, V, O, lds_generic, (long)TT, mref); }
    }
    asm volatile("s_waitcnt vmcnt(0) lgkmcnt(0)" ::: "memory");
}
__device__ __forceinline__ void p3_hyena(const Frame& F) {
    const int NCU = F.G;
    for (int c = F.vcu; c < HYW; c += NCU) hyena2_unit<NBS, LS>(F, c);
    for (int c = F.vcu; c < HYW; c += NCU) hyena2_unit<NBP, LP>(F, c);
}
__device__ __forceinline__ void p4_task(const Frame& F, int tt) {
    const bf16* yT = (const bf16*)(F.ws + WS_YT); const bf16* o = (const bf16*)(F.ws + WS_O); bf16* mixed = (bf16*)(F.ws + WS_MIX);
    const int m0 = tt * 64; int s0, L; seq_of(m0, s0, L);
    const int tl0 = m0 - s0; LAS unsigned char* lds = F.lds; constexpr int RS = 1040;
    __syncthreads();
    { const int chunk = F.tid & 7, cs = F.tid >> 3;
#pragma unroll
      for (int ps = 0; ps < 8; ++ps) { const int c = ps * 64 + cs; const v4u v = *(const GAS v4u*)(yT + (size_t)s0 * 512 + (size_t)c * L + tl0 + 8 * chunk);
        LAS unsigned short* d = (LAS unsigned short*)(lds + (8 * chunk) * RS + 2 * c);
        d[0 * (RS / 2)] = (unsigned short)v.x; d[1 * (RS / 2)] = (unsigned short)(v.x >> 16); d[2 * (RS / 2)] = (unsigned short)v.y; d[3 * (RS / 2)] = (unsigned short)(v.y >> 16);
        d[4 * (RS / 2)] = (unsigned short)v.z; d[5 * (RS / 2)] = (unsigned short)(v.z >> 16); d[6 * (RS / 2)] = (unsigned short)v.w; d[7 * (RS / 2)] = (unsigned short)(v.w >> 16); } }
    __syncthreads();
    const int lane = F.lane;
    const f32x4 gh0 = *(const GAS f32x4*)(F.in[16] + 8 * lane), gh1 = *(const GAS f32x4*)(F.in[16] + 8 * lane + 4), ga0 = *(const GAS f32x4*)(F.in[17] + 8 * lane), ga1 = *(const GAS f32x4*)(F.in[17] + 8 * lane + 4);
#pragma unroll
    for (int i = 0; i < 8; ++i) {
        const int t = F.wave * 8 + i; const size_t m = (size_t)m0 + t;
#pragma unroll
        for (int part = 0; part < 2; ++part) {
            const v4u v = part == 0 ? *(const LAS v4u*)(lds + t * RS + 16 * lane) : *(const GAS v4u*)(o + m * QW + 8 * lane);
            float f[8] = {bflo(v.x), bfhi(v.x), bflo(v.y), bfhi(v.y), bflo(v.z), bfhi(v.z), bflo(v.w), bfhi(v.w)};
            float s = 0.f;
#pragma unroll
            for (int q = 0; q < 8; ++q) s += f[q] * f[q];
            const float rstd = 1.0f / sqrtf(wave_sum(s) * (1.0f / 512.0f) + EPS);
            const f32x4 g0 = part == 0 ? gh0 : ga0, g1 = part == 0 ? gh1 : ga1;
            const v4u w = (v4u){pk2(f[0] * rstd * g0.x, f[1] * rstd * g0.y), pk2(f[2] * rstd * g0.z, f[3] * rstd * g0.w), pk2(f[4] * rstd * g1.x, f[5] * rstd * g1.y), pk2(f[6] * rstd * g1.z, f[7] * rstd * g1.w)};
            *(GAS v4u*)(mixed + m * DM + part * 512 + 8 * lane) = w;
        }
    }
}
__device__ __forceinline__ void p9_rows4(const Frame& F, int m) {
    const bf16* yb = (const bf16*)(F.ws + WS_B); const float* rsq = (const float*)(F.ws + WS_ROWSQ2);
    v4u v[4][2]; float rstd[4];
#pragma unroll
    for (int i = 0; i < 4; ++i) { rstd[i] = rsq[m + i];
#pragma unroll
        for (int j = 0; j < 2; ++j) v[i][j] = *(const GAS v4u*)(yb + (size_t)(m + i) * DM + 512 * j + 8 * F.lane); }
    f32x4 g[2][2];
#pragma unroll
    for (int j = 0; j < 2; ++j) { g[j][0] = *(const GAS f32x4*)(F.in[23] + 512 * j + 8 * F.lane); g[j][1] = *(const GAS f32x4*)(F.in[23] + 512 * j + 8 * F.lane + 4); }
#pragma unroll
    for (int i = 0; i < 4; ++i) { const float rs = 1.0f / sqrtf(rstd[i] * (1.0f / DM) + EPS);
#pragma unroll
        for (int j = 0; j < 2; ++j) { const v4u w = v[i][j]; float* o = F.out + (size_t)(m + i) * DM + 512 * j + 8 * F.lane;
            *(GAS f32x4*)o = (f32x4){bflo(w.x) * rs * g[j][0].x, bfhi(w.x) * rs * g[j][0].y, bflo(w.y) * rs * g[j][0].z, bfhi(w.y) * rs * g[j][0].w};
            *(GAS f32x4*)(o + 4) = (f32x4){bflo(w.z) * rs * g[j][1].x, bfhi(w.z) * rs * g[j][1].y, bflo(w.w) * rs * g[j][1].z, bfhi(w.w) * rs * g[j][1].w}; } }
}
#ifndef MK_N_LAUNCHES
#define MK_N_LAUNCHES 1
#endif
constexpr int N_PHASES = 10;

struct Args { const float* in[24]; float* out; unsigned char* ws; int ph_lo, ph_hi, li, pad; };
__global__ void __launch_bounds__(NWAVES * 64, 2) hymba_fwd(Args args) {
    extern __shared__ __attribute__((aligned(16))) unsigned char lds_raw[];
    cg::grid_group grid = cg::this_grid();
    Frame F;
    F.lds = (LAS unsigned char*)lds_raw;
    F.tid = threadIdx.x; F.lane = F.tid & 63; F.wave = __builtin_amdgcn_readfirstlane(F.tid >> 6);
    F.G = gridDim.x; { const int bx = blockIdx.x; F.vcu = (F.G % 8 == 0) ? (bx % 8) * (F.G / 8) + bx / 8 : bx; }
    F.in = (const __attribute__((address_space(4))) cfp*)__builtin_amdgcn_kernarg_segment_ptr();
    F.out = args.out; F.ws = args.ws;
    if (F.tid < 16) ((LAS unsigned*)(F.lds + BARST_OFF))[F.tid] = 0u;
    __syncthreads();
    XcdBarrier bar = xcd_barrier_post((unsigned*)(F.ws + WS_BAR) + args.li * XCD_BAR_WORDS, (volatile LAS unsigned*)(F.lds + BARST_OFF));
    const int lo = args.ph_lo, hi = args.ph_hi;
#define IN(k) (lo <= (k) && (k) < hi)
#define SEAM(k) do { if (IN(k) && IN((k) + 1)) { if ((k) == 0) grid.sync(); else xcd_barrier(bar); } } while (0)

    if (IN(0)) { p0_prologue(F); } SEAM(0);
    if (IN(1)) {
        pg8::Gemm g{(const pg8::bf16_t*)(F.ws + WS_B), (const pg8::bf16_t*)(F.ws + WS_WIN), TT, INC, DM}; pg8::StaticOrder S; S.init(TT, INC, F.G, (int)blockIdx.x);
        pg8::EpiBf16<0> E{(pg8::bf16_t*)(F.ws + WS_A), INC, nullptr, 0, 0, 1.f};
        pg8::gemm_phase<pg8::EpiBf16<0>, pg8::StaticOrder, PG8_ALIGN, PG8_SP2>(F.lds, g, S, E);
    } SEAM(1);
    if (IN(2)) { p2_phase(F); } SEAM(2);
    if (IN(3)) { p3_attn(F, (char*)lds_raw); }
    if (IN(4)) { p3_hyena(F); } SEAM(4);
    if (IN(5)) { for (int tt = F.vcu; tt < TT / 64; tt += F.G) p4_task(F, tt); } SEAM(5);
    if (IN(6)) {
        pg8::Gemm g{(const pg8::bf16_t*)(F.ws + WS_MIX), (const pg8::bf16_t*)(F.ws + WS_WOUT), TT, DM, DM}; pg8::StaticOrder S; S.init(TT, DM, F.G, (int)blockIdx.x);
        pg8::EpiX1 E{F.in[0], F.in[1], (pg8::bf16_t*)(F.ws + WS_B), (float*)(F.ws + WS_ROWSQ1)};
        pg8::gemm_phase<pg8::EpiX1, pg8::StaticOrder, PG8_ALIGN, PG8_SP2>(F.lds, g, S, E);
    } SEAM(6);
    if (IN(7)) {
        pg8::Gemm g{(const pg8::bf16_t*)(F.ws + WS_B), (const pg8::bf16_t*)(F.ws + WS_WGU), TT, 2 * DFF, DM}; pg8::StaticOrder S; S.init(TT, 2 * DFF, F.G, (int)blockIdx.x);
        pg8::EpiSwiGLU E{(pg8::bf16_t*)(F.ws + WS_A), (const float*)(F.ws + WS_ROWSQ1), DFF, EPS};
        pg8::gemm_phase<pg8::EpiSwiGLU, pg8::StaticOrder, PG8_ALIGN, PG8_SP2>(F.lds, g, S, E);
    } SEAM(7);
    if (IN(8)) {
        pg8::Gemm g{(const pg8::bf16_t*)(F.ws + WS_A), (const pg8::bf16_t*)(F.ws + WS_WD), TT, DM, DFF}; pg8::StaticOrder S; S.init(TT, DM, F.G, (int)blockIdx.x);
        pg8::EpiY E{(pg8::bf16_t*)(F.ws + WS_B), (float*)(F.ws + WS_ROWSQ2)};
        pg8::gemm_phase<pg8::EpiY, pg8::StaticOrder, PG8_ALIGN, PG8_SP2>(F.lds, g, S, E);
    } SEAM(8);
    if (IN(9)) { const int gw = F.vcu * NWAVES + F.wave, NGW = F.G * NWAVES; for (int m = gw * 4; m < TT; m += NGW * 4) p9_rows4(F, m); }
#undef IN
#undef SEAM
}

extern "C" void kernel_launch(void* const* d_in, const int* in_sizes, int n_in, void* d_out, int out_size, void* d_ws, size_t ws_size, hipStream_t stream) {
    static int grid = 0;
    if (grid == 0) {
        if (n_in != 24 || out_size != TT * DM || ws_size < WS_END) { fprintf(stderr, "kernel_launch: unexpected shapes (n_in %d out %d ws %zu)\n", n_in, out_size, ws_size); grid = -1; return; }
        int dev = 0, cus = 0, per_cu = 0;
        hipGetDevice(&dev); hipDeviceGetAttribute(&cus, hipDeviceAttributeMultiprocessorCount, dev);
        if (hipFuncSetAttribute((const void*)hymba_fwd, hipFuncAttributeMaxDynamicSharedMemorySize, LDS_BYTES) != hipSuccess) { fprintf(stderr, "kernel_launch: hipFuncSetAttribute failed\n"); grid = -1; return; }
        if (hipOccupancyMaxActiveBlocksPerMultiprocessor(&per_cu, (const void*)hymba_fwd, NWAVES * 64, LDS_BYTES) != hipSuccess || per_cu < 1) { fprintf(stderr, "kernel_launch: occupancy query says %d\n", per_cu); per_cu = 1; }
        (void)hipGetLastError();
        grid = cus;
        fprintf(stderr, "kernel_launch: grid %d (per_cu %d)\n", grid, per_cu);
    }
    if (grid < 0) return;
    hipMemsetAsync((char*)d_ws + WS_CTL, 0, CTL_ZERO_BYTES, stream);
    Args a{};
    for (int i = 0; i < 24; ++i) a.in[i] = (const float*)d_in[i];
    a.out = (float*)d_out; a.ws = (unsigned char*)d_ws;
#if defined(PROBE_LO)
    { const int cuts[4][2] = {{0, PROBE_HI}, {PROBE_LO, PROBE_HI}, {PROBE_HI, N_PHASES}, {0, 0}};
      for (int li = 0; li < 3; ++li) { if (cuts[li][0] >= cuts[li][1]) continue; a.ph_lo = cuts[li][0]; a.ph_hi = cuts[li][1]; a.li = li; void* kargs[] = {&a};
        hipError_t e = hipLaunchCooperativeKernel((const void*)hymba_fwd, dim3(grid), dim3(NWAVES * 64), kargs, LDS_BYTES, stream);
        if (e != hipSuccess) fprintf(stderr, "kernel_launch: launch %d failed: %s\n", li, hipGetErrorString(e)); } }
#elif MK_N_LAUNCHES == 1
    a.ph_lo = 0; a.ph_hi = N_PHASES;
    { void* kargs[] = {&a}; hipError_t e = hipLaunchCooperativeKernel((const void*)hymba_fwd, dim3(grid), dim3(NWAVES * 64), kargs, LDS_BYTES, stream);
      if (e != hipSuccess) fprintf(stderr, "kernel_launch: cooperative launch failed: %s\n", hipGetErrorString(e)); }
#else
    for (int p = 0; p < N_PHASES; ++p) { a.ph_lo = p; a.ph_hi = p + 1; a.li = 0; void* kargs[] = {&a};
      hipError_t e = hipLaunchCooperativeKernel((const void*)hymba_fwd, dim3(grid), dim3(NWAVES * 64), kargs, LDS_BYTES, stream);
      if (e != hipSuccess) fprintf(stderr, "kernel_launch: launch %d failed: %s\n", p, hipGetErrorString(e)); }
#endif
}
```

```cpp
#include <hip/hip_runtime.h>
#include <hip/hip_cooperative_groups.h>
#include <cstdio>
#include <cstdint>
namespace cg = cooperative_groups;
namespace pg8 {
#define PG8_LAS __attribute__((address_space(3)))
typedef unsigned short bf16_t;
typedef short bf16x8 __attribute__((ext_vector_type(8)));
typedef float f32x4 __attribute__((ext_vector_type(4)));
typedef unsigned u32x4 __attribute__((ext_vector_type(4)));
constexpr int BM = 256, BK = 64, HALF = 128, HTB = HALF * BK * 2  , STAGE_BYTES = 8 * HTB, NXCD = 8, WGM = 8;

__host__ __device__ __forceinline__ int lds_byte(int r, int c) { const int st = (r >> 4) * 2 + (c >> 5), rr = r & 15, cc = c & 31, ob = rr * 64 + cc * 2; return st * 1024 + (ob ^ (((ob >> 9) & 1) << 5)); }
__host__ __device__ __forceinline__ void stage_rc(int b, int& R, int& C) { const int st = b / 1024, sb = b % 1024, swz = sb ^ (((sb >> 9) & 1) << 5); R = (st >> 1) * 16 + swz / 64; C = (st & 1) * 32 + (swz % 64) / 2; }
__host__ __device__ __forceinline__ int perm32(int rho) { const int n = rho >> 4, i = rho & 15; return 8 * (i >> 2) + 4 * n + (i & 3); }

struct Unit { int pm, pn; };
struct Gemm { const bf16_t* A; const bf16_t* Bt; int M, N, K; };

struct StaticOrder {
    int nM, nN, nwg, G, c;
    __host__ __device__ void init(int M, int N, int G_, int c_) { nM = M / BM; nN = N / BM; nwg = nM * nN; G = G_; c = c_; }
    __host__ __device__ bool next(int i, Unit& u) const {
        const long L = (long)i * G + c; if (L >= nwg) return false;
        int wgid = (int)L; { const int q = nwg / NXCD, r = nwg % NXCD, xcd = wgid % NXCD, off = wgid / NXCD; wgid = (xcd < r ? xcd * (q + 1) : r * (q + 1) + (xcd - r) * q) + off; }
        const int nig = WGM * nN, gid = wgid / nig, fm = gid * WGM, gsz = (nM - fm) < WGM ? (nM - fm) : WGM;
        u.pm = fm + ((wgid % nig) % gsz); u.pn = (wgid % nig) / gsz; return true;
    }
    __device__ __forceinline__ void a_ready(const Unit&) const {}
    __device__ __forceinline__ void done(const Unit&) const {}
};

__device__ __forceinline__ unsigned cvt_pk_bf16(float lo, float hi) { unsigned r; asm volatile("v_cvt_pk_bf16_f32 %0, %1, %2" : "=v"(r) : "v"(lo), "v"(hi)); return r; }
typedef float f32x2 __attribute__((ext_vector_type(2)));
__device__ __forceinline__ f32x2 gelu_pk(f32x2 v) {
    const f32x2 av = __builtin_elementwise_abs(v), d = av * 0.2316418882f + 1.0f;
    f32x2 t; t.x = __builtin_amdgcn_rcpf(d.x); t.y = __builtin_amdgcn_rcpf(d.y);
    f32x2 q = t * 0.5307027145f + (-0.7265760135f); q = q * t + 0.7107068705f; q = q * t + (-0.142248368f); q = q * t + 0.127414796f; q = q * t;
    const f32x2 s = (v * v) * (-0.72134752044f);
    f32x2 e; e.x = __builtin_amdgcn_exp2f(s.x); e.y = __builtin_amdgcn_exp2f(s.y);
    const f32x2 m = v * (q * e), r = v - m;
    f32x2 o; o.x = v.x < 0.f ? m.x : r.x; o.y = v.y < 0.f ? m.y : r.y; return o;
}

template <int ACT  > struct EpiBf16 {
    static constexpr bool PERM = true, AFTER_DRAIN = false; static_assert(ACT == 0 || ACT == 1, "EpiBf16: ACT is 0 (none) or 1 (gelu_pk)");
    bf16_t* O; int ldc; const float* bias; int split_cols; size_t split_stride; float scale0;
    __device__ __forceinline__ void operator()(const f32x4 (&acc)[2][2][4][2], const Unit& u, int wr, int wc, int fr, int fq) const {
        const int row0 = u.pm * BM + wr * 64 + fr; int colt = u.pn * BM; bf16_t* base = O;
        float sc = 1.f; if (split_cols) { const int t = colt / split_cols; base += (size_t)t * split_stride; colt -= t * split_cols; if (t == 0) sc = scale0; }
        const int col0 = colt + wc * 32 + 8 * fq, bcol0 = u.pn * BM + wc * 32 + 8 * fq;
        f32x4 bv[2][2];
#pragma unroll
        for (int bj = 0; bj < 2; ++bj)
#pragma unroll
            for (int n = 0; n < 2; ++n) bv[bj][n] = bias ? *(const f32x4*)(bias + bcol0 + bj * HALF + 4 * n) : (f32x4){0.f, 0.f, 0.f, 0.f};
#pragma unroll
        for (int ai = 0; ai < 2; ++ai)
#pragma unroll
            for (int m = 0; m < 4; ++m) { bf16_t* rowp = base + (size_t)(row0 + ai * HALF + m * 16) * ldc + col0;
#pragma unroll
                for (int bj = 0; bj < 2; ++bj) { f32x4 v0 = acc[ai][bj][m][0] + bv[bj][0], v1 = acc[ai][bj][m][1] + bv[bj][1];
                    if (ACT == 1) { f32x2 a = gelu_pk((f32x2){v0[0], v0[1]}), b = gelu_pk((f32x2){v0[2], v0[3]}), c = gelu_pk((f32x2){v1[0], v1[1]}), d = gelu_pk((f32x2){v1[2], v1[3]});
                        v0 = (f32x4){a.x, a.y, b.x, b.y}; v1 = (f32x4){c.x, c.y, d.x, d.y}; }
                    v0 = v0 * sc; v1 = v1 * sc; u32x4 w; w.x = cvt_pk_bf16(v0[0], v0[1]); w.y = cvt_pk_bf16(v0[2], v0[3]); w.z = cvt_pk_bf16(v1[0], v1[1]); w.w = cvt_pk_bf16(v1[2], v1[3]);
                    *(u32x4*)(rowp + bj * HALF) = w; } }
    }
};

constexpr int TOK_P = 32768;
struct EpiX1 {
    static constexpr bool PERM = true, AFTER_DRAIN = false;
    const float* base0; const float* base1; bf16_t* xb; float* rowsq;
    __device__ __forceinline__ void operator()(const f32x4 (&acc)[2][2][4][2], const Unit& u, int wr, int wc, int fr, int fq) const {
        const int row0 = u.pm * BM + wr * 64 + fr, col0 = u.pn * BM + wc * 32 + 8 * fq;
#pragma unroll
        for (int ai = 0; ai < 2; ++ai)
#pragma unroll
            for (int m = 0; m < 4; ++m) {
                const int r = row0 + ai * HALF + m * 16;
                const float* brow = (r < TOK_P ? base0 + (size_t)r * 1024 : base1 + (size_t)(r - TOK_P) * 1024) + col0;
                float ss = 0.f;
#pragma unroll
                for (int bj = 0; bj < 2; ++bj) {
                    const f32x4 v0 = *(const f32x4*)(brow + bj * HALF) + acc[ai][bj][m][0], v1 = *(const f32x4*)(brow + bj * HALF + 4) + acc[ai][bj][m][1];
                    ss += (v0[0] * v0[0] + v0[1] * v0[1]) + (v0[2] * v0[2] + v0[3] * v0[3]) + (v1[0] * v1[0] + v1[1] * v1[1]) + (v1[2] * v1[2] + v1[3] * v1[3]);
                    u32x4 w; w.x = cvt_pk_bf16(v0[0], v0[1]); w.y = cvt_pk_bf16(v0[2], v0[3]); w.z = cvt_pk_bf16(v1[0], v1[1]); w.w = cvt_pk_bf16(v1[2], v1[3]);
                    *(u32x4*)(xb + (size_t)r * 1024 + col0 + bj * HALF) = w;
                }
                ss += __shfl_xor(ss, 16); ss += __shfl_xor(ss, 32);
                if (fq == 0) unsafeAtomicAdd(rowsq + r, ss);
            }
    }
};
struct EpiY {
    static constexpr bool PERM = true, AFTER_DRAIN = false;
    bf16_t* xb; float* rowsq;
    __device__ __forceinline__ void operator()(const f32x4 (&acc)[2][2][4][2], const Unit& u, int wr, int wc, int fr, int fq) const {
        const int row0 = u.pm * BM + wr * 64 + fr, col0 = u.pn * BM + wc * 32 + 8 * fq;
#pragma unroll
        for (int ai = 0; ai < 2; ++ai)
#pragma unroll
            for (int m = 0; m < 4; ++m) {
                const int r = row0 + ai * HALF + m * 16;
                bf16_t* prow = xb + (size_t)r * 1024 + col0;
                float ss = 0.f;
#pragma unroll
                for (int bj = 0; bj < 2; ++bj) {
                    const u32x4 x = *(const u32x4*)(prow + bj * HALF);
                    f32x4 v0 = acc[ai][bj][m][0], v1 = acc[ai][bj][m][1];
                    v0[0] += __builtin_bit_cast(float, x.x << 16); v0[1] += __builtin_bit_cast(float, x.x & 0xffff0000u); v0[2] += __builtin_bit_cast(float, x.y << 16); v0[3] += __builtin_bit_cast(float, x.y & 0xffff0000u);
                    v1[0] += __builtin_bit_cast(float, x.z << 16); v1[1] += __builtin_bit_cast(float, x.z & 0xffff0000u); v1[2] += __builtin_bit_cast(float, x.w << 16); v1[3] += __builtin_bit_cast(float, x.w & 0xffff0000u);
                    ss += (v0[0] * v0[0] + v0[1] * v0[1]) + (v0[2] * v0[2] + v0[3] * v0[3]) + (v1[0] * v1[0] + v1[1] * v1[1]) + (v1[2] * v1[2] + v1[3] * v1[3]);
                    u32x4 w; w.x = cvt_pk_bf16(v0[0], v0[1]); w.y = cvt_pk_bf16(v0[2], v0[3]); w.z = cvt_pk_bf16(v1[0], v1[1]); w.w = cvt_pk_bf16(v1[2], v1[3]);
                    *(u32x4*)(prow + bj * HALF) = w;
                }
                ss += __shfl_xor(ss, 16); ss += __shfl_xor(ss, 32);
                if (fq == 0) unsafeAtomicAdd(rowsq + r, ss);
            }
    }
};
struct EpiSwiGLU {
    static constexpr bool PERM = true, AFTER_DRAIN = false;
    bf16_t* act; const float* rowsq; int ldc; float eps;
    __device__ __forceinline__ void operator()(const f32x4 (&acc)[2][2][4][2], const Unit& u, int wr, int wc, int fr, int fq) const {
        const int row0 = u.pm * BM + wr * 64 + fr, col0 = u.pn * HALF + wc * 32 + 8 * fq;
#pragma unroll
        for (int ai = 0; ai < 2; ++ai)
#pragma unroll
            for (int m = 0; m < 4; ++m) {
                const int r = row0 + ai * HALF + m * 16;
                const float rstd = __builtin_amdgcn_rsqf(rowsq[r] * (1.0f / 1024.0f) + eps);
                float o[8];
#pragma unroll
                for (int n = 0; n < 2; ++n)
#pragma unroll
                    for (int i = 0; i < 4; ++i) {
                        const float g = acc[ai][0][m][n][i] * rstd, up = acc[ai][1][m][n][i] * rstd;
                        const float sg = g * __builtin_amdgcn_rcpf(1.0f + __builtin_amdgcn_exp2f(-1.4426950408889634f * g));
                        o[n * 4 + i] = sg * up;
                    }
                u32x4 w; w.x = cvt_pk_bf16(o[0], o[1]); w.y = cvt_pk_bf16(o[2], o[3]); w.z = cvt_pk_bf16(o[4], o[5]); w.w = cvt_pk_bf16(o[6], o[7]);
                *(u32x4*)(act + (size_t)r * ldc + col0) = w;
            }
    }
};

template <class Epi, class Sched, bool ALIGN_EPI = false, bool SP2 = false>
__device__ __forceinline__ void gemm_phase(PG8_LAS unsigned char* lds, const Gemm g, const Sched& S, const Epi& E) {
    const int tid = threadIdx.x, wid = __builtin_amdgcn_readfirstlane(tid >> 6), lane = tid & 63, wr = wid >> 2, wc = wid & 3, fr = lane & 15, fq = lane >> 4;
    const int K = g.K, nt = K / BK;
    unsigned voffA[2], voffB[2];
#pragma unroll
    for (int i = 0; i < 2; ++i) { int R, C; stage_rc(tid * 16 + i * 8192, R, C); const int Rb = Epi::PERM ? ((R & ~31) + perm32(R & 31)) : R;
        voffA[i] = (unsigned)(R * K + C) * 2u; voffB[i] = (unsigned)(Rb * K + C) * 2u; }
    const size_t kstep = (size_t)(BK * 2);
    const size_t hstep = (size_t)HALF * K * 2;
    const size_t tstep = 2 * hstep;
    const unsigned ldsw = (unsigned)wid * 1024u;
    const int aoff = lds_byte(wr * 64 + fr, fq * 8), boff = lds_byte(wc * 32 + fr, fq * 8);
#define PG8_SA(b, h) (((b) * 2 + (h)) * HTB)
#define PG8_SB(b, h) ((4 + (b) * 2 + (h)) * HTB)
#define PG8_STAGE(bufoff, gbase, voff) do { _Pragma("unroll") for (int _i = 0; _i < 2; ++_i) \
        __builtin_amdgcn_global_load_lds((const unsigned*)((const char*)(gbase) + (voff)[_i]), (PG8_LAS unsigned*)(lds + (bufoff) + ldsw + _i * 8192), 16, 0, 0); } while (0)
#define PG8_LDA(dst, b, h) do { _Pragma("unroll") for (int m = 0; m < 4; ++m) _Pragma("unroll") for (int k = 0; k < 2; ++k) dst[m][k] = *(const PG8_LAS bf16x8*)(lds + PG8_SA(b, h) + aoff + m * 2048 + k * 1024); } while (0)
#define PG8_LDB(dst, b, h) do { _Pragma("unroll") for (int n = 0; n < 2; ++n) _Pragma("unroll") for (int k = 0; k < 2; ++k) dst[n][k] = *(const PG8_LAS bf16x8*)(lds + PG8_SB(b, h) + boff + n * 2048 + k * 1024); } while (0)
#define PG8_MMA(ai, bj, At, Bt) do { __builtin_amdgcn_s_setprio(1); _Pragma("unroll") for (int m = 0; m < 4; ++m) _Pragma("unroll") for (int n = 0; n < 2; ++n) _Pragma("unroll") for (int k = 0; k < 2; ++k) \
        acc[ai][bj][m][n] = __builtin_amdgcn_mfma_f32_16x16x32_bf16(Bt[n][k], At[m][k], acc[ai][bj][m][n], 0, 0, 0); __builtin_amdgcn_s_setprio(0); } while (0)
#define PG8_WAIT_V(n) asm volatile("s_waitcnt vmcnt(" #n ")" ::: "memory")
#define PG8_WAIT_L(n) asm volatile("s_waitcnt lgkmcnt(" #n ")" ::: "memory")
#define PG8_BAR __builtin_amdgcn_s_barrier()
#define PG8_SCHED __builtin_amdgcn_sched_barrier(0)
    Unit cur, nxt; int ui = 0;
    if (!S.next(0, cur)) return;
    f32x4 acc[2][2][4][2];
#pragma unroll
    for (int a = 0; a < 2; ++a)
#pragma unroll
        for (int b = 0; b < 2; ++b)
#pragma unroll
            for (int m = 0; m < 4; ++m)
#pragma unroll
                for (int n = 0; n < 2; ++n) acc[a][b][m][n] = (f32x4){0.f, 0.f, 0.f, 0.f};
    bf16x8 At[4][2], B0[2][2], B1[2][2];
    const char* cA = (const char*)g.A + (size_t)cur.pm * tstep; const char* cB = (const char*)g.Bt + (size_t)cur.pn * tstep;
    S.a_ready(cur);
    if constexpr (SP2) {
        PG8_STAGE(PG8_SB(0, 0), cB, voffB); PG8_STAGE(PG8_SB(0, 1), cB + hstep, voffB); PG8_STAGE(PG8_SA(0, 0), cA, voffA); PG8_STAGE(PG8_SA(0, 1), cA + hstep, voffA);
        if (wr == 1) PG8_BAR;
        PG8_WAIT_V(2); PG8_BAR;
        PG8_STAGE(PG8_SB(1, 0), cB + kstep, voffB); PG8_STAGE(PG8_SA(1, 0), cA + kstep, voffA); PG8_STAGE(PG8_SB(1, 1), cB + hstep + kstep, voffB);
        PG8_WAIT_V(6); PG8_BAR;
    } else {
        PG8_STAGE(PG8_SB(0, 0), cB, voffB); PG8_STAGE(PG8_SA(0, 0), cA, voffA); PG8_STAGE(PG8_SB(0, 1), cB + hstep, voffB); PG8_STAGE(PG8_SA(0, 1), cA + hstep, voffA);
        if (wr == 1) PG8_BAR;
        PG8_WAIT_V(4); PG8_BAR;
        PG8_STAGE(PG8_SB(1, 0), cB + kstep, voffB); PG8_STAGE(PG8_SA(1, 0), cA + kstep, voffA); PG8_STAGE(PG8_SB(1, 1), cB + hstep + kstep, voffB);
        PG8_WAIT_V(6); PG8_BAR;
    }
    for (;;) {
        const bool has_next = S.next(ui + 1, nxt);
        const char* nA = has_next ? (const char*)g.A + (size_t)nxt.pm * tstep : cA; const char* nB = has_next ? (const char*)g.Bt + (size_t)nxt.pn * tstep : cB;
        for (int t = 0; t < nt; t += 2) {
            const bool last = (t == nt - 2);
            const char* a1 = cA + (size_t)(t + 1) * kstep;
            const char* a2 = last ? nA : cA + (size_t)(t + 2) * kstep; const char* b2 = last ? nB : cB + (size_t)(t + 2) * kstep;
            const char* a3 = a2 + kstep; const char* b3 = b2 + kstep;
            if (last && has_next) S.a_ready(nxt);
            if constexpr (SP2) {
            PG8_LDB(B0, 0, 0); PG8_LDB(B1, 0, 1); PG8_SCHED; PG8_LDA(At, 0, 0); PG8_STAGE(PG8_SA(1, 1), a1 + hstep, voffA);
            PG8_WAIT_V(8); PG8_WAIT_L(0); PG8_BAR; PG8_MMA(0, 0, At, B0); PG8_MMA(0, 1, At, B1); PG8_BAR; PG8_SCHED;
            PG8_LDA(At, 0, 1); PG8_STAGE(PG8_SB(0, 0), b2, voffB); PG8_STAGE(PG8_SB(0, 1), b2 + hstep, voffB); PG8_STAGE(PG8_SA(0, 0), a2, voffA);
            PG8_WAIT_V(8); PG8_WAIT_L(0); PG8_BAR; PG8_MMA(1, 0, At, B0); PG8_MMA(1, 1, At, B1); PG8_BAR; PG8_SCHED;
            PG8_LDB(B0, 1, 0); PG8_LDB(B1, 1, 1); PG8_SCHED; PG8_LDA(At, 1, 0); PG8_STAGE(PG8_SA(0, 1), a2 + hstep, voffA);
            PG8_WAIT_V(8); PG8_WAIT_L(0); PG8_BAR; PG8_MMA(0, 0, At, B0); PG8_MMA(0, 1, At, B1); PG8_BAR; PG8_SCHED;
            PG8_LDA(At, 1, 1); PG8_STAGE(PG8_SB(1, 0), b3, voffB); PG8_STAGE(PG8_SB(1, 1), b3 + hstep, voffB); PG8_STAGE(PG8_SA(1, 0), a3, voffA);
            PG8_WAIT_V(8); PG8_WAIT_L(0); PG8_BAR; PG8_MMA(1, 0, At, B0); PG8_MMA(1, 1, At, B1); PG8_BAR; PG8_SCHED;
            } else {
            PG8_LDB(B0, 0, 0); PG8_SCHED; PG8_LDA(At, 0, 0); PG8_STAGE(PG8_SA(1, 1), a1 + hstep, voffA);
            PG8_WAIT_L(8); PG8_BAR; PG8_WAIT_L(0); PG8_MMA(0, 0, At, B0); PG8_BAR; PG8_SCHED;
            PG8_LDB(B1, 0, 1); PG8_STAGE(PG8_SB(0, 0), b2, voffB);
            PG8_BAR; PG8_WAIT_L(0); PG8_MMA(0, 1, At, B1); PG8_BAR;
            PG8_LDA(At, 0, 1); PG8_STAGE(PG8_SA(0, 0), a2, voffA);
            PG8_BAR; PG8_WAIT_L(0); PG8_MMA(1, 0, At, B0); PG8_BAR; PG8_SCHED;
            PG8_STAGE(PG8_SB(0, 1), b2 + hstep, voffB);
            PG8_WAIT_V(6); PG8_BAR; PG8_MMA(1, 1, At, B1); PG8_BAR;
            PG8_LDB(B0, 1, 0); PG8_SCHED; PG8_LDA(At, 1, 0); PG8_STAGE(PG8_SA(0, 1), a2 + hstep, voffA);
            PG8_WAIT_L(8); PG8_BAR; PG8_WAIT_L(0); PG8_MMA(0, 0, At, B0); PG8_BAR; PG8_SCHED;
            PG8_LDB(B1, 1, 1); PG8_STAGE(PG8_SB(1, 0), b3, voffB);
            PG8_BAR; PG8_WAIT_L(0); PG8_MMA(0, 1, At, B1); PG8_BAR;
            PG8_LDA(At, 1, 1); PG8_STAGE(PG8_SA(1, 0), a3, voffA);
            PG8_BAR; PG8_WAIT_L(0); PG8_MMA(1, 0, At, B0); PG8_BAR; PG8_SCHED;
            PG8_STAGE(PG8_SB(1, 1), b3 + hstep, voffB);
            PG8_WAIT_V(6); PG8_BAR; PG8_MMA(1, 1, At, B1); PG8_BAR;
            }
        }
        if constexpr (ALIGN_EPI) { if (wr == 0) PG8_BAR; }
        if constexpr (!Epi::AFTER_DRAIN) { E(acc, cur, wr, wc, fr, fq); S.done(cur); }
        if (!has_next) break;
#pragma unroll
        for (int a = 0; a < 2; ++a)
#pragma unroll
            for (int b = 0; b < 2; ++b)
#pragma unroll
                for (int m = 0; m < 4; ++m)
#pragma unroll
                    for (int n = 0; n < 2; ++n) acc[a][b][m][n] = (f32x4){0.f, 0.f, 0.f, 0.f};
        cur = nxt; cA = nA; cB = nB; ++ui;
        if constexpr (ALIGN_EPI) { if (wr == 1) PG8_BAR; }
    }
    PG8_WAIT_V(0);
    if constexpr (!ALIGN_EPI) { if (wr == 0) PG8_BAR; }
    PG8_BAR;
    if constexpr (Epi::AFTER_DRAIN) { E.fused(acc, cur, wr, wc, fr, fq, lds, wid, lane); S.done(cur); }
#undef PG8_SA
#undef PG8_SB
#undef PG8_STAGE
#undef PG8_LDA
#undef PG8_LDB
#undef PG8_MMA
#undef PG8_WAIT_V
#undef PG8_WAIT_L
#undef PG8_BAR
#undef PG8_SCHED
}
}

#ifndef PG8_SP2
#define PG8_SP2 true
#endif
#ifndef PG8_ALIGN
#define PG8_ALIGN true
#endif
#include <hip/hip_bf16.h>
#include <cmath>
namespace attn_body {
using bf16=__hip_bfloat16;
using bf16x8=__attribute__((ext_vector_type(8)))short;
using s16x4=__attribute__((ext_vector_type(4)))short;
using f32x16=__attribute__((ext_vector_type(16)))float;
using u32x4=__attribute__((ext_vector_type(4)))unsigned;
constexpr int D=64,QP=512,KP=64;
constexpr int NW=8,QBLK=32,QB=QBLK*NW,KVBLK=64;
constexpr int ATTN_UNIT_ROWS=QB;
__device__ __forceinline__ int crow(int r,int hi){return (r&3)+8*(r>>2)+4*hi;}
#define SBAR() __builtin_amdgcn_sched_barrier(0)
__device__ __forceinline__ void cmask(f32x16&p0,f32x16&p1,int jb,int qrel,int hi){
  const float NEG=-INFINITY; int kb=64*jb+4*hi;
  #pragma unroll
  for(int r=0;r<16;++r){int kv=kb+(r&3)+8*(r>>2); if(kv>qrel)p0[r]=NEG; if(kv+32>qrel)p1[r]=NEG;}
}

constexpr int NSLOT=3, SLOTB=8192;
constexpr int LDS_K=0, LDS_V=NSLOT*SLOTB, LDS_WS=2*NSLOT*SLOTB, LDS_OST=LDS_WS+NW*64*4, LDS_BYTES=LDS_OST+NW*4096;
constexpr float C2=0.125f*1.4426950408889634f;
__device__ __forceinline__ void glds16(const void*gsrc,unsigned lds_dst){unsigned keep;
  asm volatile("s_mov_b32 %0, m0\n\ts_mov_b32 m0, %2\n\ts_nop 0\n\tglobal_load_lds_dwordx4 %1, off\n\ts_mov_b32 m0, %0":"=&s"(keep):"v"(gsrc),"s"(lds_dst):"memory");}
__device__ __forceinline__ float max3f(float a,float b,float c){float r;asm("v_max3_f32 %0, %1, %2, %3":"=v"(r):"v"(a),"v"(b),"v"(c));return r;}
__device__ __forceinline__ float max2f(float a,float b){float r;asm("v_max_f32_e32 %0, %1, %2":"=v"(r):"v"(a),"v"(b));return r;}
__device__ __forceinline__ float fadd_s(float a,float b){float r;asm("v_add_f32_e32 %0, %1, %2":"=v"(r):"v"(a),"v"(b));return r;}
__device__ __forceinline__ float fsub_s(float a,float b){float r;asm("v_sub_f32_e32 %0, %1, %2":"=v"(r):"v"(a),"v"(b));return r;}
typedef float f32x2_t __attribute__((ext_vector_type(2))); typedef __bf16 bf16x2_t __attribute__((ext_vector_type(2)));
__device__ __forceinline__ unsigned cvtpk_s(float lo,float hi){f32x2_t v={lo,hi};bf16x2_t b=__builtin_convertvector(v,bf16x2_t);return __builtin_bit_cast(unsigned,b);}
#define WAIT_BAR(N) asm volatile("s_waitcnt vmcnt(" #N ") lgkmcnt(0)\n\ts_barrier":::"memory")

__device__ __forceinline__ void qkt(f32x16&p0,f32x16&p1,const char*Kslot,const bf16x8*qr,const f32x16&negm,int r32,int hi){
  const char*kb=Kslot+hi*1024+r32*16;
  #pragma unroll
  for(int d0=0;d0<4;++d0){
    const bf16x8 b0=*reinterpret_cast<const bf16x8*>(kb+d0*2048);
    const bf16x8 b1=*reinterpret_cast<const bf16x8*>(kb+d0*2048+512);
    if(d0==0){p0=__builtin_amdgcn_mfma_f32_32x32x16_bf16(b0,qr[0],negm,0,0,0);p1=__builtin_amdgcn_mfma_f32_32x32x16_bf16(b1,qr[0],negm,0,0,0);}
    else{p0=__builtin_amdgcn_mfma_f32_32x32x16_bf16(b0,qr[d0],p0,0,0,0);p1=__builtin_amdgcn_mfma_f32_32x32x16_bf16(b1,qr[d0],p1,0,0,0);}}
}
typedef __attribute__((address_space(3))) const char* lds_cptr;
typedef short v4i16_t __attribute__((ext_vector_type(4)));
__device__ __forceinline__ void kload8(bf16x8*kf,lds_cptr kp){
  kf[0]=*(const __attribute__((address_space(3))) bf16x8*)(kp);      kf[1]=*(const __attribute__((address_space(3))) bf16x8*)(kp+512);
  kf[2]=*(const __attribute__((address_space(3))) bf16x8*)(kp+2048); kf[3]=*(const __attribute__((address_space(3))) bf16x8*)(kp+2560);
  kf[4]=*(const __attribute__((address_space(3))) bf16x8*)(kp+4096); kf[5]=*(const __attribute__((address_space(3))) bf16x8*)(kp+4608);
  kf[6]=*(const __attribute__((address_space(3))) bf16x8*)(kp+6144); kf[7]=*(const __attribute__((address_space(3))) bf16x8*)(kp+6656);
}
__device__ __forceinline__ void kload2(bf16x8*kf,lds_cptr kp,int j){ kf[2*j]=*(const __attribute__((address_space(3))) bf16x8*)(kp+j*2048); kf[2*j+1]=*(const __attribute__((address_space(3))) bf16x8*)(kp+j*2048+512); }
__device__ __forceinline__ s16x4 vtr(lds_cptr p){ return __builtin_bit_cast(s16x4,__builtin_amdgcn_ds_read_tr16_b64_v4i16((__attribute__((address_space(3))) v4i16_t*)p)); }
__device__ __forceinline__ float rowmax(const f32x16&p0,const f32x16&p1){
  float a=max3f(p0[0],p0[1],p1[0]),b=max3f(p0[2],p0[3],p1[1]);a=max3f(a,p1[2],p1[3]);
  #pragma unroll
  for(int r=4;r<16;r+=4){a=max3f(a,p0[r],p0[r+1]);b=max3f(b,p0[r+2],p0[r+3]);a=max3f(a,p1[r],p1[r+1]);b=max3f(b,p1[r+2],p1[r+3]);}
  const float m=max2f(a,b);
  auto rr=__builtin_amdgcn_permlane32_swap(__float_as_uint(m),__float_as_uint(m),false,false);
  return max2f(__uint_as_float(rr[0]),__uint_as_float(rr[1]));
}
__device__ __forceinline__ void pv(f32x16*o,int vb,bf16x8 pa0,bf16x8 pa1,bf16x8 pa2,bf16x8 pa3){
  #pragma unroll
  for(int d0=0;d0<2;++d0){s16x4 lo[4],hi[4];
    #pragma unroll
    for(int ks=0;ks<4;++ks){
      asm volatile("ds_read_b64_tr_b16 %0,%1 offset:%c2":"=&v"(lo[ks]):"v"(vb),"i"(d0*4096+ks*1024):"memory");
      asm volatile("ds_read_b64_tr_b16 %0,%1 offset:%c2":"=&v"(hi[ks]):"v"(vb),"i"(d0*4096+ks*1024+512):"memory");}
    asm volatile("s_waitcnt lgkmcnt(0)":::"memory");SBAR();
    #define PK(k) (bf16x8){lo[k][0],lo[k][1],lo[k][2],lo[k][3],hi[k][0],hi[k][1],hi[k][2],hi[k][3]}
    o[d0]=__builtin_amdgcn_mfma_f32_32x32x16_bf16(pa0,PK(0),o[d0],0,0,0);
    o[d0]=__builtin_amdgcn_mfma_f32_32x32x16_bf16(pa1,PK(1),o[d0],0,0,0);
    o[d0]=__builtin_amdgcn_mfma_f32_32x32x16_bf16(pa2,PK(2),o[d0],0,0,0);
    o[d0]=__builtin_amdgcn_mfma_f32_32x32x16_bf16(pa3,PK(3),o[d0],0,0,0);
    #undef PK
  }
}

#ifndef ATTN_STORE16
#define ATTN_STORE16(p,v) (*(u32x4*)(p)=(v))
#endif
template<int THRL> __device__ __forceinline__ void attn_unit(long qrow0,long kvrow0,int seq,int h,const bf16*Q,const bf16*__restrict__ K,const bf16*__restrict__ V,bf16*O,char*shm,long kvhstride,float mref){
  const int tid=threadIdx.x,lane=tid&63,r32=lane&31,hi=lane>>5; const int wid=__builtin_amdgcn_readfirstlane(tid>>6);
  const bf16*Qw=Q+(qrow0+wid*QBLK)*QP+h*D;
  const bf16*Kh=K+((long)(h>>2)*kvhstride+kvrow0)*KP,*Vh=V+((long)(h>>2)*kvhstride+kvrow0)*KP;
  const unsigned lds0=(unsigned)(uintptr_t)shm;
  float*wsf=(float*)(shm+LDS_WS)+wid*64;
  const bf16*ksrc=Kh+(long)lane*KP+wid*8;
  const bf16*vsrc=Vh+(long)(16*(wid&3)+(lane>>2))*KP+(wid>>2)*32+(lane&3)*8;
  const unsigned kdst=lds0+LDS_K+wid*1024, vdst=lds0+LDS_V+wid*1024;
  #define DMA_K(t,slot) glds16(ksrc+(long)(t)*KVBLK*KP,(unsigned)__builtin_amdgcn_readfirstlane(kdst+(slot)))
  #define DMA_V(t,slot) glds16(vsrc+(long)(t)*KVBLK*KP,(unsigned)__builtin_amdgcn_readfirstlane(vdst+(slot)))
  const int vb0=(int)(lds0+LDS_V)+((lane>>4)&1)*32+(lane&3)*8+(4*hi+((lane&15)>>2))*64;
  const char*Kbase=shm+LDS_K; bf16x8 kf[8];
  const lds_cptr shm3=(lds_cptr)shm; const lds_cptr kp0=shm3+LDS_K+hi*1024+r32*16; const lds_cptr vp0=shm3+LDS_V+((lane>>4)&1)*32+(lane&3)*8+(4*hi+((lane&15)>>2))*64;
  const int NT=seq/KVBLK;
  DMA_K(0,0);DMA_V(0,0);DMA_K(1,SLOTB);
  bf16x8 qr[4];
  #pragma unroll
  for(int d0=0;d0<4;++d0)qr[d0]=*reinterpret_cast<const bf16x8*>(&Qw[(long)r32*QP+d0*16+hi*8]);
  float l_reg=0.f;f32x16 o[2];o[0]=f32x16{};o[1]=f32x16{};f32x16 negm;
  #pragma unroll
  for(int r=0;r<16;++r)negm[r]=-mref;
  asm volatile("":"+v"(negm));
  #define CMASK(P0,P1,t) do{}while(0)
  bool resc=false;
  #define START(P0,P1) do{ resc=false; _Pragma("unroll") for(int r=0;r<16;++r)P0[r]=__builtin_amdgcn_exp2f(P0[r]); }while(0)
  #define RESC() do{ if(resc){ asm volatile("s_waitcnt lgkmcnt(0)":::"memory"); \
      _Pragma("unroll") for(int d_=0;d_<2;++d_) _Pragma("unroll") for(int r=0;r<16;++r)o[d_][r]*=wsf[crow(r,hi)]; } }while(0)
  f32x16 pA0,pA1,pB0,pB1;
  int sl_prev=0,sl_cur=0,sl_next=SLOTB;
  #define ROT() do{sl_prev=sl_cur;sl_cur=sl_next;sl_next=(sl_next==(NSLOT-1)*SLOTB)?0:sl_next+SLOTB;}while(0)
  DMA_K(2,2*SLOTB);
  WAIT_BAR(3);
  qkt(pA0,pA1,Kbase,qr,negm,r32,hi);asm volatile("s_nop 15\n\ts_nop 7":"+v"(pA0),"+v"(pA1));CMASK(pA0,pA1,0);
  START(pA0,pA1);
  _Pragma("unroll") for(int r=0;r<16;++r)pA1[r]=__builtin_amdgcn_exp2f(pA1[r]);
  WAIT_BAR(0);
  DMA_K(3,0);DMA_V(1,SLOTB);
  ROT();
  kload8(kf,kp0+sl_cur);
  WAIT_BAR(2);
  s16x4 vlo[8],vhi[8]; u32x4 pw0,pw1,pw2,pw3;
  #define PKW(P,B) cvtpk_s(P[B],P[B+1])
  #define PAF(k) __builtin_bit_cast(bf16x8,pw##k)
  #define VFR(i) (bf16x8){vlo[i][0],vlo[i][1],vlo[i][2],vlo[i][3],vhi[i][0],vhi[i][1],vhi[i][2],vhi[i][3]}
  #define PIN(x) asm volatile("":"+v"(x))
  #define MX3(a,b,c) __builtin_fmaxf(__builtin_fmaxf((a),(b)),(c))
  #define GAPA(MF,A0,A1,A2,A3,W0,W1,PW) do{ MF; sacc+=A0; sacc+=A1; sacc+=A2; sacc+=A3; PIN(sacc); W0; W1; PIN(PW); SBAR(); }while(0)
  #define EX(v) __builtin_amdgcn_exp2f(v)
  #define GAPB(MF,X,B) do{ MF; X[B]=EX(X[B]); X[B+1]=EX(X[B+1]); X[B+2]=EX(X[B+2]); X[B+3]=EX(X[B+3]); PIN(X); SBAR(); }while(0)
  #define VRD(i) do{ vlo[i]=vtr(vp_+(((i)>>2)*4096+((i)&3)*1024)); vhi[i]=vtr(vp_+(((i)>>2)*4096+((i)&3)*1024+512)); }while(0)
  #define KRD(G,j) do{ if(G){ kload2(kf,kp0+sl_next,j); SBAR(); } }while(0)
  #define STEP(C0,C1,P0,P1,t,GK,GV,GL) do{ SBAR(); \
    const lds_cptr vp_=vp0+sl_prev; \
    VRD(0); SBAR(); float sacc=(P0[0]+P0[1]); \
    GAPA(C0=__builtin_amdgcn_mfma_f32_32x32x16_bf16(kf[0],qr[0],negm,0,0,0), P0[2],P0[3],P0[4],P0[5],     pw0[0]=PKW(P0,0), pw0[1]=PKW(P0,2), pw0); \
    VRD(4); SBAR(); GAPA(C1=__builtin_amdgcn_mfma_f32_32x32x16_bf16(kf[1],qr[0],negm,0,0,0), P0[6],P0[7],P0[8],P0[9],     pw0[2]=PKW(P0,4), pw0[3]=PKW(P0,6), pw0); \
    VRD(1); SBAR(); GAPA(C0=__builtin_amdgcn_mfma_f32_32x32x16_bf16(kf[2],qr[1],C0,0,0,0),   P0[10],P0[11],P0[12],P0[13], pw1[0]=PKW(P0,8), pw1[1]=PKW(P0,10), pw1); \
    VRD(5); SBAR(); GAPA(C1=__builtin_amdgcn_mfma_f32_32x32x16_bf16(kf[3],qr[1],C1,0,0,0),   P0[14],P0[15],P1[0],P1[1],   pw1[2]=PKW(P0,12),pw1[3]=PKW(P0,14), pw1); \
    VRD(2); SBAR(); GAPA(C0=__builtin_amdgcn_mfma_f32_32x32x16_bf16(kf[4],qr[2],C0,0,0,0),   P1[2],P1[3],P1[4],P1[5],     pw2[0]=PKW(P1,0), pw2[1]=PKW(P1,2), pw2); \
    VRD(6); SBAR(); GAPA(C1=__builtin_amdgcn_mfma_f32_32x32x16_bf16(kf[5],qr[2],C1,0,0,0),   P1[6],P1[7],P1[8],P1[9],     pw2[2]=PKW(P1,4), pw2[3]=PKW(P1,6), pw2); \
    VRD(3); SBAR(); GAPA(C0=__builtin_amdgcn_mfma_f32_32x32x16_bf16(kf[6],qr[3],C0,0,0,0),   P1[10],P1[11],P1[12],P1[13], pw3[0]=PKW(P1,8), pw3[1]=PKW(P1,10), pw3); \
    VRD(7); SBAR(); GAPA(C1=__builtin_amdgcn_mfma_f32_32x32x16_bf16(kf[7],qr[3],C1,0,0,0),   P1[14],P1[15],0.f,0.f,       pw3[2]=PKW(P1,12),pw3[3]=PKW(P1,14), pw3); \
    l_reg+=sacc; \
    if(GK){DMA_K((t)+3,sl_cur);} if(GV){DMA_V((t)+1,sl_next);} \
    CMASK(C0,C1,t); \
    resc=false;   \
    SBAR(); \
    GAPB(o[0]=__builtin_amdgcn_mfma_f32_32x32x16_bf16(PAF(0),VFR(0),o[0],0,0,0), C0,0); \
    GAPB(o[1]=__builtin_amdgcn_mfma_f32_32x32x16_bf16(PAF(0),VFR(4),o[1],0,0,0), C0,4); \
    KRD(GL,0); GAPB(o[0]=__builtin_amdgcn_mfma_f32_32x32x16_bf16(PAF(1),VFR(1),o[0],0,0,0), C0,8); \
    KRD(GL,1); GAPB(o[1]=__builtin_amdgcn_mfma_f32_32x32x16_bf16(PAF(1),VFR(5),o[1],0,0,0), C0,12); \
    KRD(GL,2); GAPB(o[0]=__builtin_amdgcn_mfma_f32_32x32x16_bf16(PAF(2),VFR(2),o[0],0,0,0), C1,0); \
    KRD(GL,3); GAPB(o[1]=__builtin_amdgcn_mfma_f32_32x32x16_bf16(PAF(2),VFR(6),o[1],0,0,0), C1,4); \
    GAPB(o[0]=__builtin_amdgcn_mfma_f32_32x32x16_bf16(PAF(3),VFR(3),o[0],0,0,0), C1,8); \
    GAPB(o[1]=__builtin_amdgcn_mfma_f32_32x32x16_bf16(PAF(3),VFR(7),o[1],0,0,0), C1,12); \
    }while(0)
  int t=1;
  #undef CMASK
  #define CMASK(P0,P1,t) do{}while(0)
  for(;t+5<NT;t+=2){
    STEP(pB0,pB1,pA0,pA1,t,true,true,true);     WAIT_BAR(2); RESC(); ROT();
    STEP(pA0,pA1,pB0,pB1,t+1,true,true,true);   WAIT_BAR(2); RESC(); ROT();
  }
  #undef CMASK
  #define CMASK(P0,P1,t) do{}while(0)
  #define ENDW(tt) do{ if((tt)+3<NT){WAIT_BAR(2);} else if((tt)+2<NT){WAIT_BAR(1);} else {WAIT_BAR(0);} }while(0)
  for(;t+1<NT;t+=2){
    STEP(pB0,pB1,pA0,pA1,t,(t+3<NT),(t+1<NT),(t+1<NT));       ENDW(t);   RESC(); ROT();
    STEP(pA0,pA1,pB0,pB1,t+1,(t+4<NT),(t+2<NT),(t+2<NT));     ENDW(t+1); RESC(); ROT();
  }
  STEP(pB0,pB1,pA0,pA1,NT-1,false,false,false); RESC();
  { float sacc=pB0[0]+pB0[1]; _Pragma("unroll") for(int r=2;r<16;++r)sacc+=pB0[r]; _Pragma("unroll") for(int r=0;r<16;++r)sacc+=pB1[r]; l_reg+=sacc;
    pw0=(u32x4){PKW(pB0,0),PKW(pB0,2),PKW(pB0,4),PKW(pB0,6)};pw1=(u32x4){PKW(pB0,8),PKW(pB0,10),PKW(pB0,12),PKW(pB0,14)};pw2=(u32x4){PKW(pB1,0),PKW(pB1,2),PKW(pB1,4),PKW(pB1,6)};pw3=(u32x4){PKW(pB1,8),PKW(pB1,10),PKW(pB1,12),PKW(pB1,14)};
    SBAR(); pv(o,vb0+sl_cur,PAF(0),PAF(1),PAF(2),PAF(3)); }
  #undef PKW
  #undef PAF
  #undef VFR
  #undef PIN
  #undef MX3
  #undef GAPA
  #undef GAPB
  #undef EX
  #undef VRD
  #undef KRD
  #undef STEP
  #undef ENDW
  {auto rr=__builtin_amdgcn_permlane32_swap(__float_as_uint(l_reg),__float_as_uint(l_reg),false,false);l_reg=__uint_as_float(rr[0])+__uint_as_float(rr[1]);}
  if(hi==0)wsf[32+r32]=l_reg;asm volatile("s_waitcnt lgkmcnt(0)":::"memory");
  float rli[16];
  #pragma unroll
  for(int r=0;r<16;++r)rli[r]=__builtin_amdgcn_rcpf(wsf[32+crow(r,hi)]);
  bf16*Ow=O+(qrow0+wid*QBLK)*QP+h*D;
  { bf16*stg=(bf16*)(shm+LDS_OST)+wid*2048;
    #pragma unroll
    for(int r=0;r<16;++r){const int orow=crow(r,hi);
      #pragma unroll
      for(int d0=0;d0<2;++d0)stg[orow*64+d0*32+r32]=__float2bfloat16(o[d0][r]*rli[r]);}
    asm volatile("s_waitcnt lgkmcnt(0)":::"memory");
    #pragma unroll
    for(int i=0;i<4;++i){const int row=i*8+(lane>>3),ch=lane&7; const u32x4 v=*(const u32x4*)(stg+row*64+ch*8); ATTN_STORE16(Ow+(long)row*QP+ch*8,v);} }
  asm volatile("s_waitcnt lgkmcnt(0)\n\ts_barrier":::"memory");
  #undef DMA_K
  #undef DMA_V
  #undef CMASK
  #undef START
  #undef RESC
  #undef ROT
}
constexpr int ATTN_LDS_BYTES=LDS_BYTES;
#undef SBAR
#undef WAIT_BAR
}
constexpr int NWAVES = 8;
constexpr int DM = 1024, LP = 2048, LS = 8192, NBP = 16, NBS = 8;
constexpr int TOKP = NBP * LP, TOKS = NBS * LS, TT = TOKP + TOKS;
constexpr int HYW = 512, INC = 2304, DFF = 2816, QW = 512;
constexpr float EPS = 1e-6f;
constexpr float QSCALE = 0.125f * 1.4426950408889634f;
constexpr size_t MiB = 1u << 20;
constexpr size_t WS_CTL = 0, CTL_ZERO_BYTES = 1 * MiB;
constexpr size_t WS_ROWSQ1 = 0, WS_ROWSQ2 = 512 * 1024, WS_BAR = 900 * 1024, WS_QCTR = 1000 * 1024;
constexpr size_t WS_WIN = 2 * MiB, WS_WOUT = 7 * MiB, WS_WGU = 9 * MiB, WS_WD = 20 * MiB;
constexpr size_t WS_HRAW = 26 * MiB;
constexpr size_t WS_TAB = 66 * MiB;
constexpr size_t WS_A = 128 * MiB;
constexpr size_t WS_YT = WS_A, WS_MIX = WS_A + 96 * MiB, WS_O = WS_A + 288 * MiB;
constexpr size_t WS_B = 656 * MiB;
constexpr size_t WS_ZT = WS_B, WS_X0T = WS_B + 96 * MiB;
constexpr size_t WS_Q = 848 * MiB;
constexpr size_t WS_K = 944 * MiB, WS_V = 968 * MiB;
constexpr size_t WS_END = 992 * MiB;
static_assert(WS_WIN + (size_t)INC * DM * 2 <= WS_WOUT && WS_WGU + (size_t)2 * DFF * DM * 2 <= WS_WD && WS_WD + (size_t)DM * DFF * 2 <= WS_HRAW, "weights map");
static_assert(WS_A + (size_t)TT * DFF * 2 <= WS_B && WS_A + (size_t)TT * INC * 2 <= WS_B && WS_B + (size_t)TT * DM * 2 <= WS_Q && WS_Q + (size_t)TT * QW * 2 <= WS_K, "activation map");
constexpr int RING_BYTES = 131072;
constexpr int LDSCTL_OFF = RING_BYTES, ZERO_OFF = LDSCTL_OFF + 64;
constexpr int LDS_BYTES = 147456, BARST_OFF = LDS_BYTES - 64;

#define GAS __attribute__((address_space(1)))
#define LAS __attribute__((address_space(3)))
typedef unsigned short bf16;
typedef unsigned v4u __attribute__((ext_vector_type(4)));
typedef unsigned v2u __attribute__((ext_vector_type(2)));
typedef float f32x4 __attribute__((ext_vector_type(4)));
typedef float f32x16 __attribute__((ext_vector_type(16)));
typedef short s16x8 __attribute__((ext_vector_type(8)));
#define LDS_WAIT() asm volatile("s_waitcnt lgkmcnt(0)" ::: "memory")
__device__ __forceinline__ unsigned f2bf(float f) { unsigned u = __builtin_bit_cast(unsigned, f); return (u + 0x7fffu + ((u >> 16) & 1u)) >> 16; }
__device__ __forceinline__ unsigned pk2(float lo, float hi) { return f2bf(lo) | (f2bf(hi) << 16); }
__device__ __forceinline__ float bflo(unsigned w) { return __builtin_bit_cast(float, w << 16); }
__device__ __forceinline__ float bfhi(unsigned w) { return __builtin_bit_cast(float, w & 0xffff0000u); }
__device__ __forceinline__ float wave_sum(float v) {
#pragma unroll
    for (int o = 1; o < 64; o <<= 1) v += __shfl_xor(v, o);
    return v;
}
__device__ __forceinline__ float half_sum(float v) {
#pragma unroll
    for (int o = 1; o < 32; o <<= 1) v += __shfl_xor(v, o);
    return v;
}
__device__ __forceinline__ float rdlane(float v, int l) { return __builtin_bit_cast(float, __builtin_amdgcn_readlane(__builtin_bit_cast(int, v), l)); }
template <int CTRL> __device__ __forceinline__ float dpp_f(float v) { return __builtin_bit_cast(float, __builtin_amdgcn_update_dpp(0, __builtin_bit_cast(int, v), CTRL, 0xF, 0xF, true)); }
__device__ __forceinline__ float oct_sum(float v) { v += dpp_f<0xB1>(v); v += dpp_f<0x4E>(v); v += dpp_f<0x141>(v); return v; }
__device__ __forceinline__ float sin_rev(float rev) { return __builtin_amdgcn_sinf(__builtin_amdgcn_fractf(rev)); }
__device__ __forceinline__ float cos_rev(float rev) { return __builtin_amdgcn_cosf(__builtin_amdgcn_fractf(rev)); }
__device__ __forceinline__ float sin_rad(float x) { return sin_rev(x * 0.15915494309189535f); }

#define XB_TMO      128
#define XB_XCNT(j)  (256  + 64 * (j))
#define XB_XSUB(j)  (1280 + 64 * (j))
#define XB_XGEN(j)  (2304 + 64 * (j))
#define XB_TOP      3328
#define XB_TOPGEN   3392
#define XCD_BAR_WORDS 3456
#define XB_SPIN_CAP (1u << 18)

__device__ __forceinline__ unsigned xb_ld(unsigned* p)              { return __hip_atomic_load(p, __ATOMIC_RELAXED, __HIP_MEMORY_SCOPE_AGENT); }
__device__ __forceinline__ unsigned xb_add(unsigned* p, unsigned v) { return __hip_atomic_fetch_add(p, v, __ATOMIC_RELAXED, __HIP_MEMORY_SCOPE_AGENT); }
__device__ __forceinline__ unsigned xb_xcc_id() { return (unsigned)__builtin_amdgcn_s_getreg((3 << 11) | 20) & 0xFu; }
#define XB_SPIN(cond, bar) do { unsigned _sp = 0; while (cond) { __builtin_amdgcn_s_sleep(1); \
    if ((++_sp & 255u) == 0u) { if (xb_ld(&(bar)[XB_TMO])) break; if (_sp > XB_SPIN_CAP) { atomicAdd(&(bar)[XB_TMO], 1u); break; } } } } while (0)

struct XcdBarrier {
    unsigned* bar; unsigned x;
    volatile LAS unsigned* st;
};

__device__ __forceinline__ XcdBarrier xcd_barrier_post(unsigned* bar, volatile LAS unsigned* st) {
    XcdBarrier b; b.bar = bar; b.x = xb_xcc_id(); b.st = st;
    if (threadIdx.x == 0) (void)xb_add(&bar[XB_XCNT(b.x)], 1u);
    return b;
}
__device__ __forceinline__ void xcd_barrier_complete(unsigned* bar, unsigned x, unsigned& nloc, unsigned& nx) {
    const unsigned G = gridDim.x * gridDim.y * gridDim.z;
    unsigned sum, cnt, mine, sp = 0u;
    for (;;) {
        sum = 0u; cnt = 0u; mine = 0u;
#pragma unroll
        for (unsigned j = 0; j < 16; ++j) { const unsigned c = xb_ld(&bar[XB_XCNT(j)]); sum += c; cnt += (c > 0u) ? 1u : 0u; mine = (j == x) ? c : mine; }
        if (sum == G) break;
        __builtin_amdgcn_s_sleep(1);
        if ((++sp & 255u) == 0u) { if (xb_ld(&bar[XB_TMO])) break; if (sp > XB_SPIN_CAP) { atomicAdd(&bar[XB_TMO], 1u); break; } }
    }
    nloc = mine > 0u ? mine : 1u; nx = cnt > 0u ? cnt : 1u;
}

__device__ __forceinline__ void xcd_barrier(const XcdBarrier& b) {
    asm volatile("s_waitcnt vmcnt(0)" ::: "memory");
    __syncthreads();
    if (threadIdx.x == 0) {
        unsigned* bar = b.bar;
        __builtin_amdgcn_s_waitcnt(0);
        unsigned nloc = b.st[0], nx = b.st[1];
        if (nloc == 0u) { xcd_barrier_complete(bar, b.x, nloc, nx); b.st[0] = nloc; b.st[1] = nx; }
        const unsigned old = xb_add(&bar[XB_XSUB(b.x)], 1u);
        const unsigned gen = old / nloc;
        if (old + 1u == (gen + 1u) * nloc) {
            __builtin_amdgcn_fence(__ATOMIC_RELEASE, "agent");
            asm volatile("s_waitcnt vmcnt(0)" ::: "memory");
            const unsigned og = xb_add(&bar[XB_TOP], 1u);
            const unsigned tg = og / nx;
            if (og + 1u == (tg + 1u) * nx) xb_add(&bar[XB_TOPGEN], 1u);
            else XB_SPIN(xb_ld(&bar[XB_TOPGEN]) == tg, bar);
            __builtin_amdgcn_fence(__ATOMIC_ACQUIRE, "agent");
            xb_add(&bar[XB_XGEN(b.x)], 1u);
            asm volatile("s_waitcnt vmcnt(0)" ::: "memory");
        } else {
            XB_SPIN(xb_ld(&bar[XB_XGEN(b.x)]) == gen, bar);
            __builtin_amdgcn_fence(__ATOMIC_ACQUIRE, "agent");
            asm volatile("s_waitcnt vmcnt(0)" ::: "memory");
        }
    }
    __syncthreads();
}

typedef const float* cfp;
struct Frame {
    LAS unsigned char* lds;
    int tid, lane, wave, vcu, G;
    const __attribute__((address_space(4))) cfp* in;
    float* out; unsigned char* ws;
};

__device__ __forceinline__ void p0_transpose_item(const float* W, int K, int N, bf16* WT, int mode, const float* kscale, LAS float* scr, int item, int lane) {
    const int nblk = N / 32, kb = item / nblk, nb = item % nblk, k0 = 64 * kb, n0 = 32 * nb;
#pragma unroll 8
    for (int i = 0; i < 32; ++i) { const int kk = 2 * i + (lane >> 5); float v = W[(size_t)(k0 + kk) * N + n0 + (lane & 31)]; if (kscale) v *= kscale[k0 + kk]; scr[kk * 33 + (lane & 31)] = v; }
    LDS_WAIT(); asm volatile("" ::: "memory");
    const int c = lane & 7;
    const int rbase = (mode == 0) ? n0 : ((n0 >> 7) * 256 + (n0 & 127) + (mode == 2 ? 128 : 0));
#pragma unroll
    for (int j = 0; j < 4; ++j) { const int n = (lane >> 3) + 8 * j; const LAS float* s = scr + (8 * c) * 33 + n;
        v4u o; o.x = pk2(s[0 * 33], s[1 * 33]); o.y = pk2(s[2 * 33], s[3 * 33]); o.z = pk2(s[4 * 33], s[5 * 33]); o.w = pk2(s[6 * 33], s[7 * 33]);
        *(GAS v4u*)(WT + (size_t)(rbase + n) * K + k0 + 8 * c) = o; }
    LDS_WAIT(); asm volatile("" ::: "memory");
}
__device__ __forceinline__ void rms_rows4_to_bf16(const float* xrow, const float* g, bf16* orow, int lane) {
    f32x4 v[4][4]; float s[4];
#pragma unroll
    for (int i = 0; i < 4; ++i) { const GAS f32x4* xr = (const GAS f32x4*)(xrow + (size_t)i * DM) + lane; s[i] = 0.f;
#pragma unroll
        for (int j = 0; j < 4; ++j) v[i][j] = xr[64 * j]; }
#pragma unroll
    for (int i = 0; i < 4; ++i) {
#pragma unroll
        for (int j = 0; j < 4; ++j) s[i] += (v[i][j].x * v[i][j].x + v[i][j].y * v[i][j].y) + (v[i][j].z * v[i][j].z + v[i][j].w * v[i][j].w);
        s[i] = 1.0f / sqrtf(wave_sum(s[i]) * (1.f / DM) + EPS); }
    const GAS f32x4* gr = (const GAS f32x4*)g + lane;
#pragma unroll
    for (int j = 0; j < 4; ++j) { const f32x4 gg = gr[64 * j];
#pragma unroll
        for (int i = 0; i < 4; ++i) { GAS unsigned long long* o8 = (GAS unsigned long long*)(orow + (size_t)i * DM) + lane; const float rs = s[i];
            o8[64 * j] = (unsigned long long)pk2(v[i][j].x * rs * gg.x, v[i][j].y * rs * gg.y) | ((unsigned long long)pk2(v[i][j].z * rs * gg.z, v[i][j].w * rs * gg.w) << 32); } }
}
__device__ __forceinline__ void p0_filter_group(const Frame& F, int grp) {
    const int seg = grp < (LP / 8) ? 0 : 1, L = seg ? LS : LP, t0 = (seg ? grp - LP / 8 : grp) * 8, lane = F.lane;
    float* hraw = (float*)(F.ws + WS_HRAW) + (seg ? (size_t)1024 * LP : 0);
    const float fr = F.in[11][lane], b1 = F.in[7][lane], b2 = F.in[9][lane];
    const float invL = 1.0f / (float)L, invLm1 = 1.0f / (float)(L - 1);
    float h2[8];
    {
        float pre[8], h1[8];
        const float w10 = F.in[6][lane];
#pragma unroll
        for (int ti = 0; ti < 8; ++ti) pre[ti] = b1 + ((float)(t0 + ti) * invLm1) * w10;
#pragma unroll 4
        for (int j = 0; j < 16; ++j) {
            const float wc = F.in[6][(1 + j) * 64 + lane], wsn = F.in[6][(17 + j) * 64 + lane];
            const float bandL = (1e-4f + (float)j * ((15.0f - 1e-4f) / 15.0f)) * invL;
#pragma unroll
            for (int ti = 0; ti < 8; ++ti) { const float rev = (float)(t0 + ti) * bandL; pre[ti] += cos_rev(rev) * wc - sin_rev(rev) * wsn; }
        }
#pragma unroll
        for (int ti = 0; ti < 8; ++ti) { h1[ti] = sin_rad(fr * pre[ti]); pre[ti] = b2; }
#pragma unroll 8
        for (int k = 0; k < 64; ++k) {
            const float w = F.in[8][k * 64 + lane];
#pragma unroll
            for (int ti = 0; ti < 8; ++ti) pre[ti] += rdlane(h1[ti], k) * w;
        }
#pragma unroll
        for (int ti = 0; ti < 8; ++ti) h2[ti] = sin_rad(fr * pre[ti]);
    }
    {
        float acc[8][16];
#pragma unroll
        for (int ti = 0; ti < 8; ++ti)
#pragma unroll
            for (int q = 0; q < 16; ++q) acc[ti][q] = 0.f;
#pragma unroll 2
        for (int k = 0; k < 64; ++k) {
            const GAS f32x4* wr = (const GAS f32x4*)(F.in[10] + (size_t)k * 1024 + lane * 16);
            const f32x4 w0 = wr[0], w1 = wr[1], w2 = wr[2], w3 = wr[3];
#pragma unroll
            for (int ti = 0; ti < 8; ++ti) { const float hv = rdlane(h2[ti], k);
#pragma unroll
                for (int q = 0; q < 4; ++q) { acc[ti][q] += hv * w0[q]; acc[ti][4 + q] += hv * w1[q]; acc[ti][8 + q] += hv * w2[q]; acc[ti][12 + q] += hv * w3[q]; } }
        }
#pragma unroll
        for (int q = 0; q < 16; ++q) {
            const int o = lane * 16 + q;
            const float dec = fabsf(F.in[12][o]) * 1.4426950408889634f;
            f32x4 v0, v1;
#pragma unroll
            for (int ti = 0; ti < 4; ++ti) { v0[ti] = acc[ti][q] * __builtin_amdgcn_exp2f(-((float)(t0 + ti) * invLm1) * dec); v1[ti] = acc[4 + ti][q] * __builtin_amdgcn_exp2f(-((float)(t0 + 4 + ti) * invLm1) * dec); }
            GAS f32x4* dst = (GAS f32x4*)(hraw + (size_t)o * L + t0);
            dst[0] = v0; dst[1] = v1;
        }
    }
}
__device__ __forceinline__ void p0_prologue(const Frame& F) {
    LAS float* scr = (LAS float*)(F.lds + F.wave * 16384);
    const int gw = F.vcu * NWAVES + F.wave, NGW = F.G * NWAVES;
    bf16* Win_t = (bf16*)(F.ws + WS_WIN); bf16* Wout_t = (bf16*)(F.ws + WS_WOUT); bf16* Wgu_t = (bf16*)(F.ws + WS_WGU); bf16* Wd_t = (bf16*)(F.ws + WS_WD);
    constexpr int I_IN = (DM / 64) * (INC / 32), I_OUT = (DM / 64) * (DM / 32), I_G = (DM / 64) * (DFF / 32), I_D = (DFF / 64) * (DM / 32);
    constexpr int NITEMS = I_IN + I_OUT + 2 * I_G + I_D;
    if (F.wave < 5) for (int g = F.vcu * 5 + F.wave; g < (LP + LS) / 8; g += F.G * 5) p0_filter_group(F, g);
    for (int it = gw; it < NITEMS; it += NGW) {
        int r = it;
        if (r < I_IN) { p0_transpose_item(F.in[3], DM, INC, Win_t, 0, nullptr, scr, r, F.lane); continue; } r -= I_IN;
        if (r < I_OUT) { p0_transpose_item(F.in[18], DM, DM, Wout_t, 0, nullptr, scr, r, F.lane); continue; } r -= I_OUT;
        if (r < I_G) { p0_transpose_item(F.in[20], DM, DFF, Wgu_t, 1, F.in[19], scr, r, F.lane); continue; } r -= I_G;
        if (r < I_G) { p0_transpose_item(F.in[21], DM, DFF, Wgu_t, 2, F.in[19], scr, r, F.lane); continue; } r -= I_G;
        p0_transpose_item(F.in[22], DFF, DM, Wd_t, 0, nullptr, scr, r, F.lane);
    }
    bf16* hb = (bf16*)(F.ws + WS_B);
    for (int m = gw * 4; m < TT; m += NGW * 4) rms_rows4_to_bf16(m < TOKP ? F.in[0] + (size_t)m * DM : F.in[1] + (size_t)(m - TOKP) * DM, F.in[2], hb + (size_t)m * DM, F.lane);
}
__device__ __forceinline__ void seq_of(int m, int& s0, int& L) { if (m < TOKP) { L = LP; s0 = m & ~(LP - 1); } else { L = LS; s0 = TOKP + ((m - TOKP) & ~(LS - 1)); } }
__device__ __forceinline__ void p2_conv_task(const Frame& F, int tt, int cgp) {
    const bf16* proj = (const bf16*)(F.ws + WS_A); bf16* zT = (bf16*)(F.ws + WS_ZT); bf16* x0T = (bf16*)(F.ws + WS_X0T);
    const int m0 = tt * 64; int s0, L; seq_of(m0, s0, L);
    const int cp = F.lane & 31, th = F.lane >> 5, c = cgp * 64 + 2 * cp, tl0 = m0 - s0 + 32 * th;
    float w[3][3][2], bs[3][2];
#pragma unroll
    for (int g = 0; g < 3; ++g)
#pragma unroll
        for (int k = 0; k < 2; ++k) { bs[g][k] = F.in[5][g * 512 + c + k];
#pragma unroll
            for (int j = 0; j < 3; ++j) w[g][j][k] = F.in[4][j * 1536 + g * 512 + c + k]; }
    unsigned zA[16], zB[16], xA[16], xB[16];
#pragma unroll
    for (int hh = 0; hh < 2; ++hh) {
        unsigned uu[18][3];
#pragma unroll
        for (int r = 0; r < 18; ++r) { const int t = tl0 + 16 * hh + r - 1; const int tcl = t < 0 ? 0 : (t >= L ? L - 1 : t); const bf16* p = proj + (size_t)(s0 + tcl) * INC + c;
            const bool ok = (t >= 0) && (t < L); const unsigned a0 = *(const unsigned*)p, a1 = *(const unsigned*)(p + 512), a2 = *(const unsigned*)(p + 1024);
            uu[r][0] = ok ? a0 : 0u; uu[r][1] = ok ? a1 : 0u; uu[r][2] = ok ? a2 : 0u; }
#pragma unroll
        for (int r = 0; r < 16; ++r) {
            float uc[3][2];
#pragma unroll
            for (int g = 0; g < 3; ++g) {
                uc[g][0] = bs[g][0] + w[g][0][0] * bflo(uu[r][g]) + w[g][1][0] * bflo(uu[r + 1][g]) + w[g][2][0] * bflo(uu[r + 2][g]);
                uc[g][1] = bs[g][1] + w[g][0][1] * bfhi(uu[r][g]) + w[g][1][1] * bfhi(uu[r + 1][g]) + w[g][2][1] * bfhi(uu[r + 2][g]);
            }
            const unsigned za = f2bf(uc[1][0] * uc[2][0]), zb = f2bf(uc[1][1] * uc[2][1]), xa = f2bf(uc[0][0]), xb = f2bf(uc[0][1]);
            const int q = 8 * hh + (r >> 1);
            if (r & 1) { zA[q] |= za << 16; zB[q] |= zb << 16; xA[q] |= xa << 16; xB[q] |= xb << 16; }
            else { zA[q] = za; zB[q] = zb; xA[q] = xa; xB[q] = xb; }
        }
    }
    const size_t o = (size_t)s0 * 512 + (size_t)c * L + tl0;
#pragma unroll
    for (int i = 0; i < 4; ++i) {
        *(GAS v4u*)(zT + o + 8 * i) = (v4u){zA[4 * i], zA[4 * i + 1], zA[4 * i + 2], zA[4 * i + 3]};
        *(GAS v4u*)(zT + o + L + 8 * i) = (v4u){zB[4 * i], zB[4 * i + 1], zB[4 * i + 2], zB[4 * i + 3]};
        *(GAS v4u*)(x0T + o + 8 * i) = (v4u){xA[4 * i], xA[4 * i + 1], xA[4 * i + 2], xA[4 * i + 3]};
        *(GAS v4u*)(x0T + o + L + 8 * i) = (v4u){xB[4 * i], xB[4 * i + 1], xB[4 * i + 2], xB[4 * i + 3]};
    }
}
__device__ __forceinline__ void p2_qkv_task(const Frame& F, int tt) {
    const bf16* proj = (const bf16*)(F.ws + WS_A); bf16* qn = (bf16*)(F.ws + WS_Q); bf16* kn = (bf16*)(F.ws + WS_K); bf16* vb = (bf16*)(F.ws + WS_V);
    const int i8 = F.lane & 7, tk = F.lane >> 3;
    float inv[4];
#pragma unroll
    for (int q = 0; q < 4; ++q) inv[q] = __builtin_amdgcn_exp2f(-(float)((4 * i8 + q) & 15) * (13.287712379549449f / 16.0f)) * 0.15915494309189535f;
    const f32x4 gq0 = *(const GAS f32x4*)(F.in[14] + 8 * i8), gq1 = *(const GAS f32x4*)(F.in[14] + 8 * i8 + 4), gk0 = *(const GAS f32x4*)(F.in[15] + 8 * i8), gk1 = *(const GAS f32x4*)(F.in[15] + 8 * i8 + 4);
#pragma unroll 1
    for (int it = 0; it < 4; ++it) {
        const int m = tt * 32 + 8 * it + tk; int s0, L; seq_of(m, s0, L);
        const int t = m - s0; const float pos = (float)((i8 < 4) ? (t >> 6) : (t & 63));
        const bf16* row = proj + (size_t)m * INC;
        v4u hv[10], vv[2];
#pragma unroll
        for (int h = 0; h < 10; ++h) hv[h] = *(const GAS v4u*)(row + 1536 + h * 64 + 8 * i8);
#pragma unroll
        for (int h = 0; h < 2; ++h) vv[h] = *(const GAS v4u*)(row + 2176 + h * 64 + 8 * i8);
        float cs[4], sn[4];
#pragma unroll
        for (int q = 0; q < 4; ++q) { const float rev = pos * inv[q]; cs[q] = cos_rev(rev); sn[q] = sin_rev(rev); }
#pragma unroll
        for (int h = 0; h < 10; ++h) {
            float f[8] = {bflo(hv[h].x), bfhi(hv[h].x), bflo(hv[h].y), bfhi(hv[h].y), bflo(hv[h].z), bfhi(hv[h].z), bflo(hv[h].w), bfhi(hv[h].w)};
            float ss = 0.f;
#pragma unroll
            for (int q = 0; q < 8; ++q) ss += f[q] * f[q];
            const float rstd = (1.0f / sqrtf(oct_sum(ss) * (1.0f / 64.0f) + EPS)) * (h < 8 ? QSCALE : 1.0f);
            const f32x4 g0 = h < 8 ? gq0 : gk0, g1 = h < 8 ? gq1 : gk1;
            f[0] *= rstd * g0.x; f[1] *= rstd * g0.y; f[2] *= rstd * g0.z; f[3] *= rstd * g0.w; f[4] *= rstd * g1.x; f[5] *= rstd * g1.y; f[6] *= rstd * g1.z; f[7] *= rstd * g1.w;
            unsigned w[4];
#pragma unroll
            for (int q = 0; q < 4; ++q) w[q] = pk2(f[2 * q] * cs[q] - f[2 * q + 1] * sn[q], f[2 * q] * sn[q] + f[2 * q + 1] * cs[q]);
            if (h < 8) *(GAS v4u*)(qn + (size_t)m * QW + h * 64 + 8 * i8) = (v4u){w[0], w[1], w[2], w[3]};
            else *(GAS v4u*)(kn + ((size_t)(h - 8) * TT + m) * 64 + 8 * i8) = (v4u){w[0], w[1], w[2], w[3]};
        }
#pragma unroll
        for (int h = 0; h < 2; ++h) *(GAS v4u*)(vb + ((size_t)h * TT + m) * 64 + 8 * i8) = vv[h];
    }
}
__device__ __forceinline__ void p2_table_task(const Frame& F, int id) {
    const int seg = id >> 9, c = id & 511, L = seg ? LS : LP, lane = F.lane;
    const float* hraw = (const float*)(F.ws + WS_HRAW) + (seg ? (size_t)1024 * LP : 0);
    const float* hf = hraw + (size_t)c * L; const float* hbk = hraw + (size_t)(512 + c) * L;
    float s = 0.f;
#pragma unroll 8
    for (int i = lane * 4; i < L; i += 256) { const f32x4 a = *(const GAS f32x4*)(hf + i), b = *(const GAS f32x4*)(hbk + i);
        s += (fabsf(a.x) + fabsf(a.y)) + (fabsf(a.z) + fabsf(a.w)) + (i == 0 ? 0.f : fabsf(b.x)) + fabsf(b.y) + (fabsf(b.z) + fabsf(b.w)); }
    const float inv = 1.0f / wave_sum(s);
    bf16* T0 = (bf16*)(F.ws + WS_TAB) + (seg ? (size_t)512 * 2 * 2 * LP : 0) + (size_t)c * 4 * L; bf16* T1 = T0 + 2 * L;
    const int boff = 512 * L - L;
#pragma unroll 4
    for (int x0 = lane * 8; x0 < 2 * L; x0 += 512) {
        float v[9];
#pragma unroll
        for (int j = 0; j < 9; ++j) { const int x = x0 + j; const int xi = x >= 2 * L ? 2 * L - 1 : x; const float t = hf[xi <= L ? L - xi : boff + xi]; v[j] = (x == 0 || x >= 2 * L) ? 0.f : t * inv; }
        *(GAS v4u*)(T0 + x0) = (v4u){pk2(v[0], v[1]), pk2(v[2], v[3]), pk2(v[4], v[5]), pk2(v[6], v[7])};
        *(GAS v4u*)(T1 + x0) = (v4u){pk2(v[1], v[2]), pk2(v[3], v[4]), pk2(v[5], v[6]), pk2(v[7], v[8])};
    }
}
__device__ __forceinline__ void p2_phase(const Frame& F) {
    const int gw = F.vcu * NWAVES + F.wave, NGW = F.G * NWAVES;
    constexpr int N_CONV = (TT / 64) * 8, N_QKV = TT / 32, N_TAB = 0;
    for (int id = gw; id < N_CONV + N_QKV + N_TAB; id += NGW) {
        if (id < N_CONV) {
            int tt = id >> 3;
            if (NGW == 2048) {
                const int k = tt >> 8, t = tt & 255, x = t >> 5, j = (t >> 2) & 7, sub = t & 3;
                tt = 4 * (48 * x + 8 * (5 - k) + j) + sub;
            }
            p2_conv_task(F, tt, id & 7);
        }
        else if (id < N_CONV + N_QKV) p2_qkv_task(F, id - N_CONV);
        else p2_table_task(F, id - N_CONV - N_QKV);
    }
}
typedef unsigned v4u_a4 __attribute__((ext_vector_type(4), aligned(4)));
template <int NB> __device__ __forceinline__ int zaddr(int tc, int b) { return NB == 16 ? 256 * tc + 16 * b : 128 * tc + 16 * b; }
template <int TPW, int CB, int ZTOP, bool CLAMP>
__device__ __forceinline__ void hy_groups(int g0, int g1, LAS unsigned char* lds, f32x16 (&acc)[TPW], v4u (&a)[4], v4u (&bx)[TPW / 2], v4u (&by)[TPW / 2], int (&off)[4], const char*& pa, bool next_clamped) {
    constexpr int HT = TPW / 2;
#define HY_RD(dst, base, h, CL) do { _Pragma("unroll") for (int jj = 0; jj < HT; ++jj) { int ad = (base) + ((h) * HT + jj) * 2048; if (CL) ad = ad < 0 ? 0 : (ad > ZTOP ? ZTOP : ad); dst[jj] = *(const LAS v4u*)(lds + ad); } } while (0)
#define HY_MM(av, src, h) do { _Pragma("unroll") for (int jj = 0; jj < HT; ++jj) acc[(h) * HT + jj] = __builtin_amdgcn_mfma_f32_32x32x16_bf16(__builtin_bit_cast(s16x8, av), __builtin_bit_cast(s16x8, src[jj]), acc[(h) * HT + jj], 0, 0, 0); } while (0)
#define HY_SB() __builtin_amdgcn_sched_barrier(0)
    for (int g = g0; g < g1; ++g) {
        v4u an[4];
#pragma unroll
        for (int u = 0; u < 4; ++u) an[u] = *(const GAS v4u_a4*)(pa - 32 * u);
        pa -= 128;
        HY_SB();
        HY_RD(by, off[0], 1, CLAMP); HY_SB(); HY_MM(a[0], bx, 0); HY_SB(); HY_RD(bx, off[1], 0, CLAMP); HY_SB(); HY_MM(a[0], by, 1); HY_SB();
        HY_RD(by, off[1], 1, CLAMP); HY_SB(); HY_MM(a[1], bx, 0); HY_SB(); HY_RD(bx, off[2], 0, CLAMP); HY_SB(); HY_MM(a[1], by, 1); HY_SB();
        HY_RD(by, off[2], 1, CLAMP); HY_SB(); HY_MM(a[2], bx, 0); HY_SB(); HY_RD(bx, off[3], 0, CLAMP); HY_SB(); HY_MM(a[2], by, 1); HY_SB();
        HY_RD(by, off[3], 1, CLAMP); HY_SB(); HY_MM(a[3], bx, 0); HY_SB();
#pragma unroll
        for (int u = 0; u < 4; ++u) off[u] -= 8 * CB;
        if (CLAMP || (next_clamped && g + 1 == g1)) HY_RD(bx, off[0], 0, true); else HY_RD(bx, off[0], 0, false);
        HY_SB(); HY_MM(a[3], by, 1); HY_SB();
#pragma unroll
        for (int u = 0; u < 4; ++u) a[u] = an[u];
    }
#undef HY_RD
#undef HY_MM
#undef HY_SB
}
template <int NB, int L> __device__ __forceinline__ void hyena_unit(const Frame& F, int c) {
    constexpr bool SEG = (L == LS);
    constexpr int TPB = 32 / NB, NTILES = NB * (L / 32) / 32, TPW = NTILES / NWAVES, CH = L / 8, CB = NB * 16, ZB = 4096, ZIMG = NB * L * 2;
    constexpr int NSTEP = L / 16 + 2 * (TPW * TPB - 1), NG = (NSTEP + 3) / 4;
    static_assert(ZB + ZIMG + ZB <= RING_BYTES + 12288, "Z image + pads fit the LDS allocation");
    const size_t zbase = (SEG ? (size_t)TOKP * 512 : 0) + (size_t)c * L;
    const bf16* zT = (const bf16*)(F.ws + WS_ZT) + zbase; const bf16* x0T = (const bf16*)(F.ws + WS_X0T) + zbase; bf16* yT = (bf16*)(F.ws + WS_YT) + zbase;
    const bf16* T0 = (const bf16*)(F.ws + WS_TAB) + (SEG ? (size_t)512 * 2 * 2 * LP : 0) + (size_t)c * 4 * L; const bf16* T1 = T0 + 2 * L;
    LAS unsigned char* lds = F.lds;
    __syncthreads();
    for (int q = F.tid; q < 2 * ZB / 16; q += NWAVES * 64) *(LAS v4u*)(lds + (q < ZB / 16 ? q * 16 : ZIMG + q * 16)) = (v4u){0u, 0u, 0u, 0u};
    { v4u wsum = (v4u){0u, 0u, 0u, 0u};
#pragma unroll
      for (int i = 0; i < (8 * L) / (16 * NWAVES * 64); ++i) { const v4u v = *(const GAS v4u*)((const char*)T0 + (size_t)(i * NWAVES * 64 + F.tid) * 16); wsum.x |= v.x; wsum.y |= v.y; wsum.z |= v.z; wsum.w |= v.w; }
      asm volatile("" :: "v"(wsum)); }
    for (int q = F.tid; q < NB * CH; q += NWAVES * 64) { const int b = q / CH, tc = q % CH; const v4u v = *(const GAS v4u*)(zT + (size_t)b * 512 * L + tc * 8); *(LAS v4u*)(lds + ZB + zaddr<NB>(tc, b)) = v; }
    __syncthreads();
    const int lane = F.lane, n = lane & 31, kg = lane >> 5, bn = n % NB, t1o = n / NB;
    const int t1_lo = F.wave * TPW * TPB, e_max = 2 * (t1_lo + TPW * TPB - 1), e0 = e_max - 4 * NG + 1;
    const int tcg0 = 4 * (t1_lo + t1o) - 2 * e0 + kg;
    int off[4];
#pragma unroll
    for (int u = 0; u < 4; ++u) off[u] = ZB + zaddr<NB>(tcg0 - 2 * u, bn);
    const char* pa = (const char*)(((n & 1) ? T1 - 1 : T0) + (L - n + 8 * kg)) - 32 * (long)e0;
    f32x16 acc[TPW];
#pragma unroll
    for (int jj = 0; jj < TPW; ++jj) acc[jj] = f32x16{};
    v4u a[4];
#pragma unroll
    for (int u = 0; u < 4; ++u) a[u] = *(const GAS v4u_a4*)(pa - 32 * u);
    pa -= 128;
    constexpr int ZTOP = ZB + ZIMG + ZB - 16, HT = TPW / 2;
    const int t1_hi = t1_lo + TPW * TPB - 1;
    int gA = (2 * t1_hi + 1 - (CH - 1) / 2 - e0 + 3) >> 2; gA = gA < 0 ? 0 : gA;
    int gB = ((2 * t1_lo - 3 - e0) >> 2) + 1; gB = gB > NG ? NG : gB; if (gB < gA) gB = gA;
    v4u bx[HT], by[HT];
    { int ad0[HT];
#pragma unroll
      for (int jj = 0; jj < HT; ++jj) { int ad = off[0] + jj * 2048; ad0[jj] = ad < 0 ? 0 : (ad > ZTOP ? ZTOP : ad); bx[jj] = *(const LAS v4u*)(lds + ad0[jj]); } }
    hy_groups<TPW, CB, ZTOP, true>(0, gA, lds, acc, a, bx, by, off, pa, false);
    hy_groups<TPW, CB, ZTOP, false>(gA, gB, lds, acc, a, bx, by, off, pa, true);
    hy_groups<TPW, CB, ZTOP, true>(gB, NG, lds, acc, a, bx, by, off, pa, false);
    const float dc = F.in[13][c];
    int n2 = n, kg2 = kg; asm volatile("" : "+v"(n2), "+v"(kg2));
    const int bn2 = n2 % NB, t1o2 = n2 / NB;
#pragma unroll
    for (int jj = 0; jj < TPW; ++jj) {
        const int t1 = t1_lo + jj * TPB + t1o2;
        const size_t gb = (size_t)bn2 * 512 * L + 32 * t1 + 4 * kg2;
#pragma unroll
        for (int rq = 0; rq < 4; ++rq) {
            const v2u zz = *(const LAS v2u*)(lds + ZB + zaddr<NB>(4 * t1 + rq, bn2) + 8 * kg2);
            const v2u xx = *(const GAS v2u*)(x0T + gb + 8 * rq);
            const float y0 = (acc[jj][4 * rq + 0] + dc * bflo(zz.x)) * bflo(xx.x), y1 = (acc[jj][4 * rq + 1] + dc * bfhi(zz.x)) * bfhi(xx.x);
            const float y2 = (acc[jj][4 * rq + 2] + dc * bflo(zz.y)) * bflo(xx.y), y3 = (acc[jj][4 * rq + 3] + dc * bfhi(zz.y)) * bfhi(xx.y);
            *(GAS v2u*)(yT + gb + 8 * rq) = (v2u){pk2(y0, y1), pk2(y2, y3)};
        }
    }
}
typedef float f32x4_a4 __attribute__((ext_vector_type(4), aligned(4)));
template <int L> __device__ __forceinline__ void hyena_build_table(const Frame& F, int c, int tid, bf16* T0, LAS float* red) {
    constexpr bool SEG = (L == LS);
    const float* hf = (const float*)(F.ws + WS_HRAW) + (SEG ? (size_t)1024 * LP : 0) + (size_t)c * L; const float* hbk = hf + (size_t)512 * L;
    float s = 0.f;
#pragma unroll
    for (int i = 0; i < L / 2048; ++i) { const int t = (tid + i * 512) * 4; const f32x4 a = *(const GAS f32x4*)(hf + t), b = *(const GAS f32x4*)(hbk + t);
        s += (fabsf(a.x) + fabsf(a.y)) + (fabsf(a.z) + fabsf(a.w)) + (t == 0 ? 0.f : fabsf(b.x)) + fabsf(b.y) + (fabsf(b.z) + fabsf(b.w)); }
    s = wave_sum(s);
    if ((tid & 63) == 0) red[tid >> 6] = s;
    __syncthreads();
    float tot = 0.f;
#pragma unroll
    for (int w = 0; w < NWAVES; ++w) tot += red[w];
    const float inv = 1.0f / tot;
    bf16* T1 = T0 + 2 * L;
#pragma unroll
    for (int i = 0; i < L / 2048; ++i) {
        const int x0 = (tid + i * 512) * 8;
        float v[9];
        if (x0 < L) {
            const f32x4 p = *(const GAS f32x4_a4*)(hf + L - x0 - 8), q = *(const GAS f32x4_a4*)(hf + L - x0 - 4); const float r0 = (x0 == 0) ? 0.f : hf[L - x0];
            v[0] = r0; v[1] = q.w; v[2] = q.z; v[3] = q.y; v[4] = q.x; v[5] = p.w; v[6] = p.z; v[7] = p.y; v[8] = p.x;
        } else {
            const int m = x0 - L; const f32x4 p = *(const GAS f32x4*)(hbk + m), q = *(const GAS f32x4*)(hbk + m + 4); const float r8 = (m + 8 >= L) ? 0.f : hbk[m + 8];
            v[0] = (m == 0) ? hf[0] : p.x; v[1] = p.y; v[2] = p.z; v[3] = p.w; v[4] = q.x; v[5] = q.y; v[6] = q.z; v[7] = q.w; v[8] = r8;
        }
#pragma unroll
        for (int j = 0; j < 9; ++j) v[j] *= inv;
        *(GAS v4u*)(T0 + x0) = (v4u){pk2(v[0], v[1]), pk2(v[2], v[3]), pk2(v[4], v[5]), pk2(v[6], v[7])};
        *(GAS v4u*)(T1 + x0) = (v4u){pk2(v[1], v[2]), pk2(v[3], v[4]), pk2(v[5], v[6]), pk2(v[7], v[8])};
    }
}
template <int TPW, int CB, int ZTOP, bool CLAMP, int JLO = 0, int JHI = TPW / 2>
__device__ __forceinline__ void hy2_groups(int g0, int g1, LAS unsigned char* lds, f32x16 (&acc)[TPW], v4u (&a)[6], v4u (&bx)[TPW / 2], v4u (&by)[TPW / 2], int (&off)[4], const char*& pa, bool next_clamped) {
    constexpr int NC = TPW / 2;
#define HY_RD(dst, base, CL) do { _Pragma("unroll") for (int jc = JLO; jc < JHI; ++jc) { int ad = (base) + jc * 4096; if (CL) ad = ad < 0 ? 0 : (ad > ZTOP ? ZTOP : ad); dst[jc] = *(const LAS v4u*)(lds + ad); } } while (0)
#define HY_MM(a0, a1, src) do { _Pragma("unroll") for (int jc = JLO; jc < JHI; ++jc) { \
        acc[2 * jc] = __builtin_amdgcn_mfma_f32_32x32x16_bf16(__builtin_bit_cast(s16x8, a0), __builtin_bit_cast(s16x8, src[jc]), acc[2 * jc], 0, 0, 0); \
        acc[2 * jc + 1] = __builtin_amdgcn_mfma_f32_32x32x16_bf16(__builtin_bit_cast(s16x8, a1), __builtin_bit_cast(s16x8, src[jc]), acc[2 * jc + 1], 0, 0, 0); } } while (0)
#define HY_SB() __builtin_amdgcn_sched_barrier(0)
#define HY_RDALL(dst, base, CL) do { _Pragma("unroll") for (int jc = 0; jc < NC; ++jc) { int ad = (base) + jc * 4096; if (CL) ad = ad < 0 ? 0 : (ad > ZTOP ? ZTOP : ad); dst[jc] = *(const LAS v4u*)(lds + ad); } } while (0)
    for (int g = g0; g < g1; ++g) {
        v4u an[4];
#pragma unroll
        for (int q = 0; q < 4; ++q) an[q] = *(const GAS v4u_a4*)(pa - 32 * q);
        pa -= 128;
        HY_SB();
        HY_RD(by, off[1], CLAMP); HY_SB(); HY_MM(a[0], a[2], bx); HY_SB();
        HY_RD(bx, off[2], CLAMP); HY_SB(); HY_MM(a[1], a[3], by); HY_SB();
        HY_RD(by, off[3], CLAMP); HY_SB(); HY_MM(a[2], a[4], bx); HY_SB();
#pragma unroll
        for (int v = 0; v < 4; ++v) off[v] -= 8 * CB;
        if (CLAMP || (next_clamped && g + 1 == g1)) HY_RDALL(bx, off[0], true); else HY_RDALL(bx, off[0], false);
        HY_SB(); HY_MM(a[3], a[5], by); HY_SB();
        a[0] = a[4]; a[1] = a[5];
#pragma unroll
        for (int q = 0; q < 4; ++q) a[2 + q] = an[q];
    }
#undef HY_RD
#undef HY_MM
#undef HY_SB
#undef HY_RDALL
}
template <int NB, int L> __device__ __forceinline__ void hyena2_unit(const Frame& F, int c) {
    constexpr bool SEG = (L == LS);
    constexpr int TPB = 32 / NB, NTILES = NB * (L / 32) / 32, TPW = NTILES / NWAVES, NC = TPW / 2, CH = L / 8, CB = NB * 16, ZB = 4096, ZIMG = NB * L * 2;
    constexpr int USPAN = NC * TPB;
    constexpr int NSTEP = L / 16 + 4 * (USPAN - 1), NG = NSTEP / 4;
    static_assert(NSTEP % 4 == 0 && ZB + ZIMG + ZB <= LDS_BYTES - 64, "hyena2 geometry");
    const size_t zbase = (SEG ? (size_t)TOKP * 512 : 0) + (size_t)c * L;
    const bf16* zT = (const bf16*)(F.ws + WS_ZT) + zbase; const bf16* x0T = (const bf16*)(F.ws + WS_X0T) + zbase; bf16* yT = (bf16*)(F.ws + WS_YT) + zbase;
    const bf16* T0 = (const bf16*)(F.ws + WS_TAB) + (SEG ? (size_t)512 * 2 * 2 * LP : 0) + (size_t)c * 4 * L; const bf16* T1 = T0 + 2 * L;
    LAS unsigned char* lds = F.lds;
    int tid = F.tid; asm volatile("" : "+v"(tid));
    __syncthreads();
    hyena_build_table<L>(F, c, tid, (bf16*)T0, (LAS float*)(lds + LDS_BYTES - 256));
    for (int q = tid; q < 2 * ZB / 16; q += NWAVES * 64) *(LAS v4u*)(lds + (q < ZB / 16 ? q * 16 : ZIMG + q * 16)) = (v4u){0u, 0u, 0u, 0u};
    { constexpr int NIT = NB * CH / (NWAVES * 64);
#pragma unroll
      for (int i0 = 0; i0 < NIT; i0 += 8) { v4u v[8];
#pragma unroll
        for (int i = 0; i < 8; ++i) { const int q = tid + (i0 + i) * NWAVES * 64, b = q / CH, tc = q % CH; v[i] = *(const GAS v4u*)(zT + (size_t)b * 512 * L + tc * 8); }
#pragma unroll
        for (int i = 0; i < 8; ++i) { const int q = tid + (i0 + i) * NWAVES * 64, b = q / CH, tc = q % CH; *(LAS v4u*)(lds + ZB + zaddr<NB>(tc, b)) = v[i]; } } }
    asm volatile("s_waitcnt vmcnt(0)" ::: "memory");
    __syncthreads();
    const int lane = tid & 63, n = lane & 31, kg = lane >> 5, bn = n % NB, uo = n / NB;
    const int u_lo = F.wave * USPAN, u_hi = u_lo + USPAN - 1, e0 = 4 * u_lo - L / 16 + 1;
    const int tcg0 = 8 * (u_lo + uo) - 2 * e0 + kg;
    int off[4];
#pragma unroll
    for (int v = 0; v < 4; ++v) off[v] = ZB + zaddr<NB>(tcg0 - 2 * v, bn);
    const char* pa = (const char*)(((n & 1) ? T1 - 1 : T0) + (L - n + 8 * kg)) - 32 * (long)e0;
    f32x16 acc[TPW];
#pragma unroll
    for (int jj = 0; jj < TPW; ++jj) acc[jj] = f32x16{};
    v4u a[6];
#pragma unroll
    for (int q = 0; q < 6; ++q) a[q] = *(const GAS v4u_a4*)(pa - 32 * q);
    pa -= 192;
    constexpr int ZTOP = ZB + ZIMG + ZB - 16;
    int gA = (4 * u_hi + 1 - (CH - 1) / 2 - e0 + 3) >> 2; gA = gA < 0 ? 0 : gA;
    int gB = ((4 * u_lo - 3 - e0) >> 2) + 1; gB = gB > NG ? NG : gB; if (gB < gA) gB = gA;
    v4u bx[NC], by[NC];
#pragma unroll
    for (int jc = 0; jc < NC; ++jc) { int ad = off[0] + jc * 4096; ad = ad < 0 ? 0 : (ad > ZTOP ? ZTOP : ad); bx[jc] = *(const LAS v4u*)(lds + ad); }
    constexpr int G_ALL0 = TPB * (NC - 1), G_ALL1 = L / 64 + TPB - 1;
    static_assert(G_ALL1 + (NC - 1) * TPB == NG && (NC == 4 || NC == 2), "segment map");
    gA = gA < G_ALL0 ? G_ALL0 : gA; gB = gB > G_ALL1 ? G_ALL1 : gB; if (gB < gA) gB = gA;
    if constexpr (NC == 4) {
        hy2_groups<TPW, CB, ZTOP, true, 0, 1>(0, TPB, lds, acc, a, bx, by, off, pa, false);
        hy2_groups<TPW, CB, ZTOP, true, 0, 2>(TPB, 2 * TPB, lds, acc, a, bx, by, off, pa, false);
        hy2_groups<TPW, CB, ZTOP, true, 0, 3>(2 * TPB, 3 * TPB, lds, acc, a, bx, by, off, pa, false);
    } else {
        hy2_groups<TPW, CB, ZTOP, true, 0, 1>(0, TPB, lds, acc, a, bx, by, off, pa, false);
    }
    hy2_groups<TPW, CB, ZTOP, true>(G_ALL0, gA, lds, acc, a, bx, by, off, pa, false);
    hy2_groups<TPW, CB, ZTOP, false>(gA, gB, lds, acc, a, bx, by, off, pa, true);
    hy2_groups<TPW, CB, ZTOP, true>(gB, G_ALL1, lds, acc, a, bx, by, off, pa, false);
    if constexpr (NC == 4) {
        hy2_groups<TPW, CB, ZTOP, true, 1, 4>(G_ALL1, G_ALL1 + TPB, lds, acc, a, bx, by, off, pa, false);
        hy2_groups<TPW, CB, ZTOP, true, 2, 4>(G_ALL1 + TPB, G_ALL1 + 2 * TPB, lds, acc, a, bx, by, off, pa, false);
        hy2_groups<TPW, CB, ZTOP, true, 3, 4>(G_ALL1 + 2 * TPB, NG, lds, acc, a, bx, by, off, pa, false);
    } else {
        hy2_groups<TPW, CB, ZTOP, true, 1, 2>(G_ALL1, NG, lds, acc, a, bx, by, off, pa, false);
    }
    const float dc = F.in[13][c];
    int n2 = n, kg2 = kg; asm volatile("" : "+v"(n2), "+v"(kg2));
    const int bn2 = n2 % NB, uo2 = n2 / NB;
#pragma unroll
    for (int jj = 0; jj < TPW; ++jj) {
        const int t1 = 2 * (u_lo + (jj >> 1) * TPB + uo2) + (jj & 1); const size_t gb = (size_t)bn2 * 512 * L + 32 * t1 + 8 * kg2;
        v4u X[2];
#pragma unroll
        for (int pr = 0; pr < 2; ++pr) X[pr] = *(const GAS v4u*)(x0T + gb + 16 * pr);
#pragma unroll
        for (int pr = 0; pr < 2; ++pr) {
            const unsigned s0 = kg2 ? X[pr].x : X[pr].z, s1 = kg2 ? X[pr].y : X[pr].w;
            const auto r0 = __builtin_amdgcn_permlane32_swap(s0, s0, false, false); const auto r1 = __builtin_amdgcn_permlane32_swap(s1, s1, false, false);
            const unsigned rc0 = kg2 ? r0[0] : r0[1], rc1 = kg2 ? r1[0] : r1[1];
            v2u xq[2];
            xq[0] = kg2 ? (v2u){rc0, rc1} : (v2u){X[pr].x, X[pr].y};
            xq[1] = kg2 ? (v2u){X[pr].z, X[pr].w} : (v2u){rc0, rc1};
            v2u wq[2];
#pragma unroll
            for (int e = 0; e < 2; ++e) { const int rq = 2 * pr + e;
                const v2u zz = *(const LAS v2u*)(lds + ZB + zaddr<NB>(4 * t1 + rq, bn2) + 8 * kg2);
                const float y0 = (acc[jj][4 * rq + 0] + dc * bflo(zz.x)) * bflo(xq[e].x), y1 = (acc[jj][4 * rq + 1] + dc * bfhi(zz.x)) * bfhi(xq[e].x);
                const float y2 = (acc[jj][4 * rq + 2] + dc * bflo(zz.y)) * bflo(xq[e].y), y3 = (acc[jj][4 * rq + 3] + dc * bfhi(zz.y)) * bfhi(xq[e].y);
                wq[e] = (v2u){pk2(y0, y1), pk2(y2, y3)}; }
            const unsigned t0 = kg2 ? wq[0].x : wq[1].x, t1s = kg2 ? wq[0].y : wq[1].y;
            const auto q0 = __builtin_amdgcn_permlane32_swap(t0, t0, false, false); const auto q1 = __builtin_amdgcn_permlane32_swap(t1s, t1s, false, false);
            const unsigned g0 = kg2 ? q0[0] : q0[1], g1 = kg2 ? q1[0] : q1[1];
            const v4u outp = kg2 ? (v4u){g0, g1, wq[1].x, wq[1].y} : (v4u){wq[0].x, wq[0].y, g0, g1};
            *(GAS v4u*)(yT + gb + 16 * pr) = outp;
        }
    }
}
__device__ __forceinline__ void p3_attn(const Frame& F, char* lds_generic) {
    using abf = attn_body::bf16;
    const abf* Q = (const abf*)(F.ws + WS_Q); const abf* K = (const abf*)(F.ws + WS_K); const abf* V = (const abf*)(F.ws + WS_V); abf* O = (abf*)(F.ws + WS_O);
    const int NCU = F.G;
    float gqm = fabsf(F.in[14][F.lane]), gkm = fabsf(F.in[15][F.lane]);
#pragma unroll
    for (int o = 1; o < 64; o <<= 1) { gqm = fmaxf(gqm, __shfl_xor(gqm, o)); gkm = fmaxf(gkm, __shfl_xor(gkm, o)); }
    const float mref = 64.0f * QSCALE * gqm * gkm * 1.02f;
    if (NCU == 256) {
        const int x = F.vcu >> 5, j = F.vcu & 31;
        for (int i = 0; i < 8; ++i) { const int p = 2 * x + (i >> 2), hh = i & 3, b = p >> 1, kvh = p & 1;
            attn_body::attn_unit<8>((long)TOKP + (long)b * LS + (long)j * 256, (long)TOKP + (long)b * LS, LS, kvh * 4 + hh, Q, K, V, O, lds_generic, (long)TT, mref); }
        for (int i = 0; i < 4; ++i) { const int p = 4 * x + i, hh = j >> 3, qb = j & 7, b = p >> 1, kvh = p & 1;
            attn_body::attn_unit<8>((long)b * LP + (long)qb * 256, (long)b * LP, LP, kvh * 4 + hh, Q, K, V, O, lds_generic, (long)TT, mref); }
    } else {
        for (int u = F.vcu; u < 2048; u += NCU) { const int p = u >> 7, hh = (u >> 5) & 3, qb = u & 31, b = p >> 1, kvh = p & 1;
            attn_body::attn_unit<8>((long)TOKP + (long)b * LS + (long)qb * 256, (long)TOKP + (long)b * LS, LS, kvh * 4 + hh, Q, K, V, O, lds_generic, (long)TT, mref); }
        for (int u = F.vcu; u < 1024; u += NCU) { const int p = u >> 5, hh = (u >> 3) & 3, qb = u & 7, b = p >> 1, kvh = p & 1;
            attn_body::attn_unit<8>((long)b * LP + (long)qb * 256, (long)b * LP, LP, kvh * 4 + hh, Q, K, V, O, lds_generic, (long)TT, mref); }
    }
    asm volatile("s_waitcnt vmcnt(0) lgkmcnt(0)" ::: "memory");
}
__device__ __forceinline__ void p3_hyena(const Frame& F) {
    const int NCU = F.G;
    for (int c = F.vcu; c < HYW; c += NCU) hyena2_unit<NBS, LS>(F, c);
    for (int c = F.vcu; c < HYW; c += NCU) hyena2_unit<NBP, LP>(F, c);
}
__device__ __forceinline__ void p4_task(const Frame& F, int tt) {
    const bf16* yT = (const bf16*)(F.ws + WS_YT); const bf16* o = (const bf16*)(F.ws + WS_O); bf16* mixed = (bf16*)(F.ws + WS_MIX);
    const int m0 = tt * 64; int s0, L; seq_of(m0, s0, L);
    const int tl0 = m0 - s0; LAS unsigned char* lds = F.lds; constexpr int RS = 1040;
    __syncthreads();
    { const int chunk = F.tid & 7, cs = F.tid >> 3;
#pragma unroll
      for (int ps = 0; ps < 8; ++ps) { const int c = ps * 64 + cs; const v4u v = *(const GAS v4u*)(yT + (size_t)s0 * 512 + (size_t)c * L + tl0 + 8 * chunk);
        LAS unsigned short* d = (LAS unsigned short*)(lds + (8 * chunk) * RS + 2 * c);
        d[0 * (RS / 2)] = (unsigned short)v.x; d[1 * (RS / 2)] = (unsigned short)(v.x >> 16); d[2 * (RS / 2)] = (unsigned short)v.y; d[3 * (RS / 2)] = (unsigned short)(v.y >> 16);
        d[4 * (RS / 2)] = (unsigned short)v.z; d[5 * (RS / 2)] = (unsigned short)(v.z >> 16); d[6 * (RS / 2)] = (unsigned short)v.w; d[7 * (RS / 2)] = (unsigned short)(v.w >> 16); } }
    __syncthreads();
    const int lane = F.lane;
    const f32x4 gh0 = *(const GAS f32x4*)(F.in[16] + 8 * lane), gh1 = *(const GAS f32x4*)(F.in[16] + 8 * lane + 4), ga0 = *(const GAS f32x4*)(F.in[17] + 8 * lane), ga1 = *(const GAS f32x4*)(F.in[17] + 8 * lane + 4);
#pragma unroll
    for (int i = 0; i < 8; ++i) {
        const int t = F.wave * 8 + i; const size_t m = (size_t)m0 + t;
#pragma unroll
        for (int part = 0; part < 2; ++part) {
            const v4u v = part == 0 ? *(const LAS v4u*)(lds + t * RS + 16 * lane) : *(const GAS v4u*)(o + m * QW + 8 * lane);
            float f[8] = {bflo(v.x), bfhi(v.x), bflo(v.y), bfhi(v.y), bflo(v.z), bfhi(v.z), bflo(v.w), bfhi(v.w)};
            float s = 0.f;
#pragma unroll
            for (int q = 0; q < 8; ++q) s += f[q] * f[q];
            const float rstd = 1.0f / sqrtf(wave_sum(s) * (1.0f / 512.0f) + EPS);
            const f32x4 g0 = part == 0 ? gh0 : ga0, g1 = part == 0 ? gh1 : ga1;
            const v4u w = (v4u){pk2(f[0] * rstd * g0.x, f[1] * rstd * g0.y), pk2(f[2] * rstd * g0.z, f[3] * rstd * g0.w), pk2(f[4] * rstd * g1.x, f[5] * rstd * g1.y), pk2(f[6] * rstd * g1.z, f[7] * rstd * g1.w)};
            *(GAS v4u*)(mixed + m * DM + part * 512 + 8 * lane) = w;
        }
    }
}
__device__ __forceinline__ void p9_rows4(const Frame& F, int m) {
    const bf16* yb = (const bf16*)(F.ws + WS_B); const float* rsq = (const float*)(F.ws + WS_ROWSQ2);
    v4u v[4][2]; float rstd[4];
#pragma unroll
    for (int i = 0; i < 4; ++i) { rstd[i] = rsq[m + i];
#pragma unroll
        for (int j = 0; j < 2; ++j) v[i][j] = *(const GAS v4u*)(yb + (size_t)(m + i) * DM + 512 * j + 8 * F.lane); }
    f32x4 g[2][2];
#pragma unroll
    for (int j = 0; j < 2; ++j) { g[j][0] = *(const GAS f32x4*)(F.in[23] + 512 * j + 8 * F.lane); g[j][1] = *(const GAS f32x4*)(F.in[23] + 512 * j + 8 * F.lane + 4); }
#pragma unroll
    for (int i = 0; i < 4; ++i) { const float rs = 1.0f / sqrtf(rstd[i] * (1.0f / DM) + EPS);
#pragma unroll
        for (int j = 0; j < 2; ++j) { const v4u w = v[i][j]; float* o = F.out + (size_t)(m + i) * DM + 512 * j + 8 * F.lane;
            *(GAS f32x4*)o = (f32x4){bflo(w.x) * rs * g[j][0].x, bfhi(w.x) * rs * g[j][0].y, bflo(w.y) * rs * g[j][0].z, bfhi(w.y) * rs * g[j][0].w};
            *(GAS f32x4*)(o + 4) = (f32x4){bflo(w.z) * rs * g[j][1].x, bfhi(w.z) * rs * g[j][1].y, bflo(w.w) * rs * g[j][1].z, bfhi(w.w) * rs * g[j][1].w}; } }
}
#ifndef MK_N_LAUNCHES
#define MK_N_LAUNCHES 1
#endif
constexpr int N_PHASES = 10;

struct Args { const float* in[24]; float* out; unsigned char* ws; int ph_lo, ph_hi, li, pad; };
__global__ void __launch_bounds__(NWAVES * 64, 2) hymba_fwd(Args args) {
    extern __shared__ __attribute__((aligned(16))) unsigned char lds_raw[];
    cg::grid_group grid = cg::this_grid();
    Frame F;
    F.lds = (LAS unsigned char*)lds_raw;
    F.tid = threadIdx.x; F.lane = F.tid & 63; F.wave = __builtin_amdgcn_readfirstlane(F.tid >> 6);
    F.G = gridDim.x; { const int bx = blockIdx.x; F.vcu = (F.G % 8 == 0) ? (bx % 8) * (F.G / 8) + bx / 8 : bx; }
    F.in = (const __attribute__((address_space(4))) cfp*)__builtin_amdgcn_kernarg_segment_ptr();
    F.out = args.out; F.ws = args.ws;
    if (F.tid < 16) ((LAS unsigned*)(F.lds + BARST_OFF))[F.tid] = 0u;
    __syncthreads();
    XcdBarrier bar = xcd_barrier_post((unsigned*)(F.ws + WS_BAR) + args.li * XCD_BAR_WORDS, (volatile LAS unsigned*)(F.lds + BARST_OFF));
    const int lo = args.ph_lo, hi = args.ph_hi;
#define IN(k) (lo <= (k) && (k) < hi)
#define SEAM(k) do { if (IN(k) && IN((k) + 1)) { if ((k) == 0) grid.sync(); else xcd_barrier(bar); } } while (0)

    if (IN(0)) { p0_prologue(F); } SEAM(0);
    if (IN(1)) {
        pg8::Gemm g{(const pg8::bf16_t*)(F.ws + WS_B), (const pg8::bf16_t*)(F.ws + WS_WIN), TT, INC, DM}; pg8::StaticOrder S; S.init(TT, INC, F.G, (int)blockIdx.x);
        pg8::EpiBf16<0> E{(pg8::bf16_t*)(F.ws + WS_A), INC, nullptr, 0, 0, 1.f};
        pg8::gemm_phase<pg8::EpiBf16<0>, pg8::StaticOrder, PG8_ALIGN, PG8_SP2>(F.lds, g, S, E);
    } SEAM(1);
    if (IN(2)) { p2_phase(F); } SEAM(2);
    if (IN(3)) { p3_attn(F, (char*)lds_raw); }
    if (IN(4)) { p3_hyena(F); } SEAM(4);
    if (IN(5)) { for (int tt = F.vcu; tt < TT / 64; tt += F.G) p4_task(F, tt); } SEAM(5);
    if (IN(6)) {
        pg8::Gemm g{(const pg8::bf16_t*)(F.ws + WS_MIX), (const pg8::bf16_t*)(F.ws + WS_WOUT), TT, DM, DM}; pg8::StaticOrder S; S.init(TT, DM, F.G, (int)blockIdx.x);
        pg8::EpiX1 E{F.in[0], F.in[1], (pg8::bf16_t*)(F.ws + WS_B), (float*)(F.ws + WS_ROWSQ1)};
        pg8::gemm_phase<pg8::EpiX1, pg8::StaticOrder, PG8_ALIGN, PG8_SP2>(F.lds, g, S, E);
    } SEAM(6);
    if (IN(7)) {
        pg8::Gemm g{(const pg8::bf16_t*)(F.ws + WS_B), (const pg8::bf16_t*)(F.ws + WS_WGU), TT, 2 * DFF, DM}; pg8::StaticOrder S; S.init(TT, 2 * DFF, F.G, (int)blockIdx.x);
        pg8::EpiSwiGLU E{(pg8::bf16_t*)(F.ws + WS_A), (const float*)(F.ws + WS_ROWSQ1), DFF, EPS};
        pg8::gemm_phase<pg8::EpiSwiGLU, pg8::StaticOrder, PG8_ALIGN, PG8_SP2>(F.lds, g, S, E);
    } SEAM(7);
    if (IN(8)) {
        pg8::Gemm g{(const pg8::bf16_t*)(F.ws + WS_A), (const pg8::bf16_t*)(F.ws + WS_WD), TT, DM, DFF}; pg8::StaticOrder S; S.init(TT, DM, F.G, (int)blockIdx.x);
        pg8::EpiY E{(pg8::bf16_t*)(F.ws + WS_B), (float*)(F.ws + WS_ROWSQ2)};
        pg8::gemm_phase<pg8::EpiY, pg8::StaticOrder, PG8_ALIGN, PG8_SP2>(F.lds, g, S, E);
    } SEAM(8);
    if (IN(9)) { const int gw = F.vcu * NWAVES + F.wave, NGW = F.G * NWAVES; for (int m = gw * 4; m < TT; m += NGW * 4) p9_rows4(F, m); }
#undef IN
#undef SEAM
}

extern "C" void kernel_launch(void* const* d_in, const int* in_sizes, int n_in, void* d_out, int out_size, void* d_ws, size_t ws_size, hipStream_t stream) {
    static int grid = 0;
    if (grid == 0) {
        if (n_in != 24 || out_size != TT * DM || ws_size < WS_END) { fprintf(stderr, "kernel_launch: unexpected shapes (n_in %d out %d ws %zu)\n", n_in, out_size, ws_size); grid = -1; return; }
        int dev = 0, cus = 0, per_cu = 0;
        hipGetDevice(&dev); hipDeviceGetAttribute(&cus, hipDeviceAttributeMultiprocessorCount, dev);
        if (hipFuncSetAttribute((const void*)hymba_fwd, hipFuncAttributeMaxDynamicSharedMemorySize, LDS_BYTES) != hipSuccess) { fprintf(stderr, "kernel_launch: hipFuncSetAttribute failed\n"); grid = -1; return; }
        if (hipOccupancyMaxActiveBlocksPerMultiprocessor(&per_cu, (const void*)hymba_fwd, NWAVES * 64, LDS_BYTES) != hipSuccess || per_cu < 1) { fprintf(stderr, "kernel_launch: occupancy query says %d\n", per_cu); per_cu = 1; }
        (void)hipGetLastError();
        grid = cus;
        fprintf(stderr, "kernel_launch: grid %d (per_cu %d)\n", grid, per_cu);
    }
    if (grid < 0) return;
    hipMemsetAsync((char*)d_ws + WS_CTL, 0, CTL_ZERO_BYTES, stream);
    Args a{};
    for (int i = 0; i < 24; ++i) a.in[i] = (const float*)d_in[i];
    a.out = (float*)d_out; a.ws = (unsigned char*)d_ws;
#if defined(PROBE_LO)
    { const int cuts[4][2] = {{0, PROBE_HI}, {PROBE_LO, PROBE_HI}, {PROBE_HI, N_PHASES}, {0, 0}};
      for (int li = 0; li < 3; ++li) { if (cuts[li][0] >= cuts[li][1]) continue; a.ph_lo = cuts[li][0]; a.ph_hi = cuts[li][1]; a.li = li; void* kargs[] = {&a};
        hipError_t e = hipLaunchCooperativeKernel((const void*)hymba_fwd, dim3(grid), dim3(NWAVES * 64), kargs, LDS_BYTES, stream);
        if (e != hipSuccess) fprintf(stderr, "kernel_launch: launch %d failed: %s\n", li, hipGetErrorString(e)); } }
#elif MK_N_LAUNCHES == 1
    a.ph_lo = 0; a.ph_hi = N_PHASES;
    { void* kargs[] = {&a}; hipError_t e = hipLaunchCooperativeKernel((const void*)hymba_fwd, dim3(grid), dim3(NWAVES * 64), kargs, LDS_BYTES, stream);
      if (e != hipSuccess) fprintf(stderr, "kernel_launch: cooperative launch failed: %s\n", hipGetErrorString(e)); }
#else
    for (int p = 0; p < N_PHASES; ++p) { a.ph_lo = p; a.ph_hi = p + 1; a.li = 0; void* kargs[] = {&a};
      hipError_t e = hipLaunchCooperativeKernel((const void*)hymba_fwd, dim3(grid), dim3(NWAVES * 64), kargs, LDS_BYTES, stream);
      if (e != hipSuccess) fprintf(stderr, "kernel_launch: launch %d failed: %s\n", p, hipGetErrorString(e)); }
#endif
}
```

```cpp
#include <hip/hip_runtime.h>
#include <hip/hip_cooperative_groups.h>
#include <cstdio>
#include <cstdint>
namespace cg = cooperative_groups;
namespace pg8 {
#define PG8_LAS __attribute__((address_space(3)))
typedef unsigned short bf16_t;
typedef short bf16x8 __attribute__((ext_vector_type(8)));
typedef float f32x4 __attribute__((ext_vector_type(4)));
typedef unsigned u32x4 __attribute__((ext_vector_type(4)));
constexpr int BM = 256, BK = 64, HALF = 128, HTB = HALF * BK * 2  , STAGE_BYTES = 8 * HTB, NXCD = 8, WGM = 8;

__host__ __device__ __forceinline__ int lds_byte(int r, int c) { const int st = (r >> 4) * 2 + (c >> 5), rr = r & 15, cc = c & 31, ob = rr * 64 + cc * 2; return st * 1024 + (ob ^ (((ob >> 9) & 1) << 5)); }
__host__ __device__ __forceinline__ void stage_rc(int b, int& R, int& C) { const int st = b / 1024, sb = b % 1024, swz = sb ^ (((sb >> 9) & 1) << 5); R = (st >> 1) * 16 + swz / 64; C = (st & 1) * 32 + (swz % 64) / 2; }
__host__ __device__ __forceinline__ int perm32(int rho) { const int n = rho >> 4, i = rho & 15; return 8 * (i >> 2) + 4 * n + (i & 3); }

struct Unit { int pm, pn; };
struct Gemm { const bf16_t* A; const bf16_t* Bt; int M, N, K; };

struct StaticOrder {
    int nM, nN, nwg, G, c, rev;
    __host__ __device__ void init(int M, int N, int G_, int c_) { nM = M / BM; nN = N / BM; nwg = nM * nN; G = G_; c = c_; rev = 0; }
    __host__ __device__ bool next(int i, Unit& u) const {
        const long L = (long)i * G + c; if (L >= nwg) return false;
        int wgid = (int)L; { const int q = nwg / NXCD, r = nwg % NXCD, xcd = wgid % NXCD, off = wgid / NXCD; wgid = (xcd < r ? xcd * (q + 1) : r * (q + 1) + (xcd - r) * q) + off; }
        if (rev) { const int q = nwg / NXCD, ngx = WGM * nN, xr = wgid / q, in = wgid % q, ng = q / ngx; wgid = xr * q + (ng - 1 - in / ngx) * ngx + in % ngx; }
        const int nig = WGM * nN, gid = wgid / nig, fm = gid * WGM, gsz = (nM - fm) < WGM ? (nM - fm) : WGM;
        u.pm = fm + ((wgid % nig) % gsz); u.pn = (wgid % nig) / gsz; return true;
    }
    __device__ __forceinline__ void a_ready(const Unit&) const {}
    __device__ __forceinline__ void done(const Unit&) const {}
};

__device__ __forceinline__ unsigned cvt_pk_bf16(float lo, float hi) { unsigned r; asm volatile("v_cvt_pk_bf16_f32 %0, %1, %2" : "=v"(r) : "v"(lo), "v"(hi)); return r; }
typedef float f32x2 __attribute__((ext_vector_type(2)));
__device__ __forceinline__ f32x2 gelu_pk(f32x2 v) {
    const f32x2 av = __builtin_elementwise_abs(v), d = av * 0.2316418882f + 1.0f;
    f32x2 t; t.x = __builtin_amdgcn_rcpf(d.x); t.y = __builtin_amdgcn_rcpf(d.y);
    f32x2 q = t * 0.5307027145f + (-0.7265760135f); q = q * t + 0.7107068705f; q = q * t + (-0.142248368f); q = q * t + 0.127414796f; q = q * t;
    const f32x2 s = (v * v) * (-0.72134752044f);
    f32x2 e; e.x = __builtin_amdgcn_exp2f(s.x); e.y = __builtin_amdgcn_exp2f(s.y);
    const f32x2 m = v * (q * e), r = v - m;
    f32x2 o; o.x = v.x < 0.f ? m.x : r.x; o.y = v.y < 0.f ? m.y : r.y; return o;
}

template <int ACT  > struct EpiBf16 {
    static constexpr bool PERM = true, AFTER_DRAIN = false; static_assert(ACT == 0 || ACT == 1, "EpiBf16: ACT is 0 (none) or 1 (gelu_pk)");
    bf16_t* O; int ldc; const float* bias; int split_cols; size_t split_stride; float scale0;
    __device__ __forceinline__ void operator()(const f32x4 (&acc)[2][2][4][2], const Unit& u, int wr, int wc, int fr, int fq) const {
        const int row0 = u.pm * BM + wr * 64 + fr; int colt = u.pn * BM; bf16_t* base = O;
        float sc = 1.f; if (split_cols) { const int t = colt / split_cols; base += (size_t)t * split_stride; colt -= t * split_cols; if (t == 0) sc = scale0; }
        const int col0 = colt + wc * 32 + 8 * fq, bcol0 = u.pn * BM + wc * 32 + 8 * fq;
        f32x4 bv[2][2];
#pragma unroll
        for (int bj = 0; bj < 2; ++bj)
#pragma unroll
            for (int n = 0; n < 2; ++n) bv[bj][n] = bias ? *(const f32x4*)(bias + bcol0 + bj * HALF + 4 * n) : (f32x4){0.f, 0.f, 0.f, 0.f};
#pragma unroll
        for (int ai = 0; ai < 2; ++ai)
#pragma unroll
            for (int m = 0; m < 4; ++m) { bf16_t* rowp = base + (size_t)(row0 + ai * HALF + m * 16) * ldc + col0;
#pragma unroll
                for (int bj = 0; bj < 2; ++bj) { f32x4 v0 = acc[ai][bj][m][0] + bv[bj][0], v1 = acc[ai][bj][m][1] + bv[bj][1];
                    if (ACT == 1) { f32x2 a = gelu_pk((f32x2){v0[0], v0[1]}), b = gelu_pk((f32x2){v0[2], v0[3]}), c = gelu_pk((f32x2){v1[0], v1[1]}), d = gelu_pk((f32x2){v1[2], v1[3]});
                        v0 = (f32x4){a.x, a.y, b.x, b.y}; v1 = (f32x4){c.x, c.y, d.x, d.y}; }
                    v0 = v0 * sc; v1 = v1 * sc; u32x4 w; w.x = cvt_pk_bf16(v0[0], v0[1]); w.y = cvt_pk_bf16(v0[2], v0[3]); w.z = cvt_pk_bf16(v1[0], v1[1]); w.w = cvt_pk_bf16(v1[2], v1[3]);
                    *(u32x4*)(rowp + bj * HALF) = w; } }
    }
};

constexpr int TOK_P = 32768;
struct EpiX1 {
    static constexpr bool PERM = true, AFTER_DRAIN = false;
    const float* base0; const float* base1; bf16_t* xb; float* rowsq;
    __device__ __forceinline__ void operator()(const f32x4 (&acc)[2][2][4][2], const Unit& u, int wr, int wc, int fr, int fq) const {
        const int row0 = u.pm * BM + wr * 64 + fr, col0 = u.pn * BM + wc * 32 + 8 * fq;
#pragma unroll
        for (int ai = 0; ai < 2; ++ai)
#pragma unroll
            for (int m = 0; m < 4; ++m) {
                const int r = row0 + ai * HALF + m * 16;
                const float* brow = (r < TOK_P ? base0 + (size_t)r * 1024 : base1 + (size_t)(r - TOK_P) * 1024) + col0;
                float ss = 0.f;
#pragma unroll
                for (int bj = 0; bj < 2; ++bj) {
                    const f32x4 v0 = *(const f32x4*)(brow + bj * HALF) + acc[ai][bj][m][0], v1 = *(const f32x4*)(brow + bj * HALF + 4) + acc[ai][bj][m][1];
                    ss += (v0[0] * v0[0] + v0[1] * v0[1]) + (v0[2] * v0[2] + v0[3] * v0[3]) + (v1[0] * v1[0] + v1[1] * v1[1]) + (v1[2] * v1[2] + v1[3] * v1[3]);
                    u32x4 w; w.x = cvt_pk_bf16(v0[0], v0[1]); w.y = cvt_pk_bf16(v0[2], v0[3]); w.z = cvt_pk_bf16(v1[0], v1[1]); w.w = cvt_pk_bf16(v1[2], v1[3]);
                    *(u32x4*)(xb + (size_t)r * 1024 + col0 + bj * HALF) = w;
                }
                ss += __shfl_xor(ss, 16); ss += __shfl_xor(ss, 32);
                if (fq == 0) unsafeAtomicAdd(rowsq + r, ss);
            }
    }
};
struct EpiY {
    static constexpr bool PERM = true, AFTER_DRAIN = false;
    bf16_t* xb; float* rowsq;
    __device__ __forceinline__ void operator()(const f32x4 (&acc)[2][2][4][2], const Unit& u, int wr, int wc, int fr, int fq) const {
        const int row0 = u.pm * BM + wr * 64 + fr, col0 = u.pn * BM + wc * 32 + 8 * fq;
#pragma unroll
        for (int ai = 0; ai < 2; ++ai)
#pragma unroll
            for (int m = 0; m < 4; ++m) {
                const int r = row0 + ai * HALF + m * 16;
                bf16_t* prow = xb + (size_t)r * 1024 + col0;
                float ss = 0.f;
#pragma unroll
                for (int bj = 0; bj < 2; ++bj) {
                    const u32x4 x = *(const u32x4*)(prow + bj * HALF);
                    f32x4 v0 = acc[ai][bj][m][0], v1 = acc[ai][bj][m][1];
                    v0[0] += __builtin_bit_cast(float, x.x << 16); v0[1] += __builtin_bit_cast(float, x.x & 0xffff0000u); v0[2] += __builtin_bit_cast(float, x.y << 16); v0[3] += __builtin_bit_cast(float, x.y & 0xffff0000u);
                    v1[0] += __builtin_bit_cast(float, x.z << 16); v1[1] += __builtin_bit_cast(float, x.z & 0xffff0000u); v1[2] += __builtin_bit_cast(float, x.w << 16); v1[3] += __builtin_bit_cast(float, x.w & 0xffff0000u);
                    ss += (v0[0] * v0[0] + v0[1] * v0[1]) + (v0[2] * v0[2] + v0[3] * v0[3]) + (v1[0] * v1[0] + v1[1] * v1[1]) + (v1[2] * v1[2] + v1[3] * v1[3]);
                    u32x4 w; w.x = cvt_pk_bf16(v0[0], v0[1]); w.y = cvt_pk_bf16(v0[2], v0[3]); w.z = cvt_pk_bf16(v1[0], v1[1]); w.w = cvt_pk_bf16(v1[2], v1[3]);
                    *(u32x4*)(prow + bj * HALF) = w;
                }
                ss += __shfl_xor(ss, 16); ss += __shfl_xor(ss, 32);
                if (fq == 0) unsafeAtomicAdd(rowsq + r, ss);
            }
    }
};
struct EpiSwiGLU {
    static constexpr bool PERM = true, AFTER_DRAIN = false;
    bf16_t* act; const float* rowsq; int ldc; float eps;
    __device__ __forceinline__ void operator()(const f32x4 (&acc)[2][2][4][2], const Unit& u, int wr, int wc, int fr, int fq) const {
        const int row0 = u.pm * BM + wr * 64 + fr, col0 = u.pn * HALF + wc * 32 + 8 * fq;
#pragma unroll
        for (int ai = 0; ai < 2; ++ai)
#pragma unroll
            for (int m = 0; m < 4; ++m) {
                const int r = row0 + ai * HALF + m * 16;
                const float rstd = __builtin_amdgcn_rsqf(rowsq[r] * (1.0f / 1024.0f) + eps);
                float o[8];
#pragma unroll
                for (int n = 0; n < 2; ++n)
#pragma unroll
                    for (int i = 0; i < 4; ++i) {
                        const float g = acc[ai][0][m][n][i] * rstd, up = acc[ai][1][m][n][i] * rstd;
                        const float sg = g * __builtin_amdgcn_rcpf(1.0f + __builtin_amdgcn_exp2f(-1.4426950408889634f * g));
                        o[n * 4 + i] = sg * up;
                    }
                u32x4 w; w.x = cvt_pk_bf16(o[0], o[1]); w.y = cvt_pk_bf16(o[2], o[3]); w.z = cvt_pk_bf16(o[4], o[5]); w.w = cvt_pk_bf16(o[6], o[7]);
                *(u32x4*)(act + (size_t)r * ldc + col0) = w;
            }
    }
};

template <class Epi, class Sched, bool ALIGN_EPI = false, bool SP2 = false>
__device__ __forceinline__ void gemm_phase(PG8_LAS unsigned char* lds, const Gemm g, const Sched& S, const Epi& E) {
    const int tid = threadIdx.x, wid = __builtin_amdgcn_readfirstlane(tid >> 6), lane = tid & 63, wr = wid >> 2, wc = wid & 3, fr = lane & 15, fq = lane >> 4;
    const int K = g.K, nt = K / BK;
    unsigned voffA[2], voffB[2];
#pragma unroll
    for (int i = 0; i < 2; ++i) { int R, C; stage_rc(tid * 16 + i * 8192, R, C); const int Rb = Epi::PERM ? ((R & ~31) + perm32(R & 31)) : R;
        voffA[i] = (unsigned)(R * K + C) * 2u; voffB[i] = (unsigned)(Rb * K + C) * 2u; }
    const size_t kstep = (size_t)(BK * 2);
    const size_t hstep = (size_t)HALF * K * 2;
    const size_t tstep = 2 * hstep;
    const unsigned ldsw = (unsigned)wid * 1024u;
    const int aoff = lds_byte(wr * 64 + fr, fq * 8), boff = lds_byte(wc * 32 + fr, fq * 8);
#define PG8_SA(b, h) (((b) * 2 + (h)) * HTB)
#define PG8_SB(b, h) ((4 + (b) * 2 + (h)) * HTB)
#define PG8_STAGE(bufoff, gbase, voff) do { _Pragma("unroll") for (int _i = 0; _i < 2; ++_i) \
        __builtin_amdgcn_global_load_lds((const unsigned*)((const char*)(gbase) + (voff)[_i]), (PG8_LAS unsigned*)(lds + (bufoff) + ldsw + _i * 8192), 16, 0, 0); } while (0)
#define PG8_LDA(dst, b, h) do { _Pragma("unroll") for (int m = 0; m < 4; ++m) _Pragma("unroll") for (int k = 0; k < 2; ++k) dst[m][k] = *(const PG8_LAS bf16x8*)(lds + PG8_SA(b, h) + aoff + m * 2048 + k * 1024); } while (0)
#define PG8_LDB(dst, b, h) do { _Pragma("unroll") for (int n = 0; n < 2; ++n) _Pragma("unroll") for (int k = 0; k < 2; ++k) dst[n][k] = *(const PG8_LAS bf16x8*)(lds + PG8_SB(b, h) + boff + n * 2048 + k * 1024); } while (0)
#define PG8_MMA(ai, bj, At, Bt) do { __builtin_amdgcn_s_setprio(1); _Pragma("unroll") for (int m = 0; m < 4; ++m) _Pragma("unroll") for (int n = 0; n < 2; ++n) _Pragma("unroll") for (int k = 0; k < 2; ++k) \
        acc[ai][bj][m][n] = __builtin_amdgcn_mfma_f32_16x16x32_bf16(Bt[n][k], At[m][k], acc[ai][bj][m][n], 0, 0, 0); __builtin_amdgcn_s_setprio(0); } while (0)
#define PG8_WAIT_V(n) asm volatile("s_waitcnt vmcnt(" #n ")" ::: "memory")
#define PG8_WAIT_L(n) asm volatile("s_waitcnt lgkmcnt(" #n ")" ::: "memory")
#define PG8_BAR __builtin_amdgcn_s_barrier()
#define PG8_SCHED __builtin_amdgcn_sched_barrier(0)
    Unit cur, nxt; int ui = 0;
    if (!S.next(0, cur)) return;
    f32x4 acc[2][2][4][2];
#pragma unroll
    for (int a = 0; a < 2; ++a)
#pragma unroll
        for (int b = 0; b < 2; ++b)
#pragma unroll
            for (int m = 0; m < 4; ++m)
#pragma unroll
                for (int n = 0; n < 2; ++n) acc[a][b][m][n] = (f32x4){0.f, 0.f, 0.f, 0.f};
    bf16x8 At[4][2], B0[2][2], B1[2][2];
    const char* cA = (const char*)g.A + (size_t)cur.pm * tstep; const char* cB = (const char*)g.Bt + (size_t)cur.pn * tstep;
    S.a_ready(cur);
    if constexpr (SP2) {
        PG8_STAGE(PG8_SB(0, 0), cB, voffB); PG8_STAGE(PG8_SB(0, 1), cB + hstep, voffB); PG8_STAGE(PG8_SA(0, 0), cA, voffA); PG8_STAGE(PG8_SA(0, 1), cA + hstep, voffA);
        if (wr == 1) PG8_BAR;
        PG8_WAIT_V(2); PG8_BAR;
        PG8_STAGE(PG8_SB(1, 0), cB + kstep, voffB); PG8_STAGE(PG8_SA(1, 0), cA + kstep, voffA); PG8_STAGE(PG8_SB(1, 1), cB + hstep + kstep, voffB);
        PG8_WAIT_V(6); PG8_BAR;
    } else {
        PG8_STAGE(PG8_SB(0, 0), cB, voffB); PG8_STAGE(PG8_SA(0, 0), cA, voffA); PG8_STAGE(PG8_SB(0, 1), cB + hstep, voffB); PG8_STAGE(PG8_SA(0, 1), cA + hstep, voffA);
        if (wr == 1) PG8_BAR;
        PG8_WAIT_V(4); PG8_BAR;
        PG8_STAGE(PG8_SB(1, 0), cB + kstep, voffB); PG8_STAGE(PG8_SA(1, 0), cA + kstep, voffA); PG8_STAGE(PG8_SB(1, 1), cB + hstep + kstep, voffB);
        PG8_WAIT_V(6); PG8_BAR;
    }
    for (;;) {
        const bool has_next = S.next(ui + 1, nxt);
        const char* nA = has_next ? (const char*)g.A + (size_t)nxt.pm * tstep : cA; const char* nB = has_next ? (const char*)g.Bt + (size_t)nxt.pn * tstep : cB;
        for (int t = 0; t < nt; t += 2) {
            const bool last = (t == nt - 2);
            const char* a1 = cA + (size_t)(t + 1) * kstep;
            const char* a2 = last ? nA : cA + (size_t)(t + 2) * kstep; const char* b2 = last ? nB : cB + (size_t)(t + 2) * kstep;
            const char* a3 = a2 + kstep; const char* b3 = b2 + kstep;
            if (last && has_next) S.a_ready(nxt);
            if constexpr (SP2) {
            PG8_LDB(B0, 0, 0); PG8_LDB(B1, 0, 1); PG8_SCHED; PG8_LDA(At, 0, 0); PG8_STAGE(PG8_SA(1, 1), a1 + hstep, voffA);
            PG8_WAIT_V(8); PG8_WAIT_L(0); PG8_BAR; PG8_MMA(0, 0, At, B0); PG8_MMA(0, 1, At, B1); PG8_BAR; PG8_SCHED;
            PG8_LDA(At, 0, 1); PG8_STAGE(PG8_SB(0, 0), b2, voffB); PG8_STAGE(PG8_SB(0, 1), b2 + hstep, voffB); PG8_STAGE(PG8_SA(0, 0), a2, voffA);
            PG8_WAIT_V(8); PG8_WAIT_L(0); PG8_BAR; PG8_MMA(1, 0, At, B0); PG8_MMA(1, 1, At, B1); PG8_BAR; PG8_SCHED;
            PG8_LDB(B0, 1, 0); PG8_LDB(B1, 1, 1); PG8_SCHED; PG8_LDA(At, 1, 0); PG8_STAGE(PG8_SA(0, 1), a2 + hstep, voffA);
            PG8_WAIT_V(8); PG8_WAIT_L(0); PG8_BAR; PG8_MMA(0, 0, At, B0); PG8_MMA(0, 1, At, B1); PG8_BAR; PG8_SCHED;
            PG8_LDA(At, 1, 1); PG8_STAGE(PG8_SB(1, 0), b3, voffB); PG8_STAGE(PG8_SB(1, 1), b3 + hstep, voffB); PG8_STAGE(PG8_SA(1, 0), a3, voffA);
            PG8_WAIT_V(8); PG8_WAIT_L(0); PG8_BAR; PG8_MMA(1, 0, At, B0); PG8_MMA(1, 1, At, B1); PG8_BAR; PG8_SCHED;
            } else {
            PG8_LDB(B0, 0, 0); PG8_SCHED; PG8_LDA(At, 0, 0); PG8_STAGE(PG8_SA(1, 1), a1 + hstep, voffA);
            PG8_WAIT_L(8); PG8_BAR; PG8_WAIT_L(0); PG8_MMA(0, 0, At, B0); PG8_BAR; PG8_SCHED;
            PG8_LDB(B1, 0, 1); PG8_STAGE(PG8_SB(0, 0), b2, voffB);
            PG8_BAR; PG8_WAIT_L(0); PG8_MMA(0, 1, At, B1); PG8_BAR;
            PG8_LDA(At, 0, 1); PG8_STAGE(PG8_SA(0, 0), a2, voffA);
            PG8_BAR; PG8_WAIT_L(0); PG8_MMA(1, 0, At, B0); PG8_BAR; PG8_SCHED;
            PG8_STAGE(PG8_SB(0, 1), b2 + hstep, voffB);
            PG8_WAIT_V(6); PG8_BAR; PG8_MMA(1, 1, At, B1); PG8_BAR;
            PG8_LDB(B0, 1, 0); PG8_SCHED; PG8_LDA(At, 1, 0); PG8_STAGE(PG8_SA(0, 1), a2 + hstep, voffA);
            PG8_WAIT_L(8); PG8_BAR; PG8_WAIT_L(0); PG8_MMA(0, 0, At, B0); PG8_BAR; PG8_SCHED;
            PG8_LDB(B1, 1, 1); PG8_STAGE(PG8_SB(1, 0), b3, voffB);
            PG8_BAR; PG8_WAIT_L(0); PG8_MMA(0, 1, At, B1); PG8_BAR;
            PG8_LDA(At, 1, 1); PG8_STAGE(PG8_SA(1, 0), a3, voffA);
            PG8_BAR; PG8_WAIT_L(0); PG8_MMA(1, 0, At, B0); PG8_BAR; PG8_SCHED;
            PG8_STAGE(PG8_SB(1, 1), b3 + hstep, voffB);
            PG8_WAIT_V(6); PG8_BAR; PG8_MMA(1, 1, At, B1); PG8_BAR;
            }
        }
        if constexpr (ALIGN_EPI) { if (wr == 0) PG8_BAR; }
        if constexpr (!Epi::AFTER_DRAIN) { E(acc, cur, wr, wc, fr, fq); S.done(cur); }
        if (!has_next) break;
#pragma unroll
        for (int a = 0; a < 2; ++a)
#pragma unroll
            for (int b = 0; b < 2; ++b)
#pragma unroll
                for (int m = 0; m < 4; ++m)
#pragma unroll
                    for (int n = 0; n < 2; ++n) acc[a][b][m][n] = (f32x4){0.f, 0.f, 0.f, 0.f};
        cur = nxt; cA = nA; cB = nB; ++ui;
        if constexpr (ALIGN_EPI) { if (wr == 1) PG8_BAR; }
    }
    PG8_WAIT_V(0);
    if constexpr (!ALIGN_EPI) { if (wr == 0) PG8_BAR; }
    PG8_BAR;
    if constexpr (Epi::AFTER_DRAIN) { E.fused(acc, cur, wr, wc, fr, fq, lds, wid, lane); S.done(cur); }
#undef PG8_SA
#undef PG8_SB
#undef PG8_STAGE
#undef PG8_LDA
#undef PG8_LDB
#undef PG8_MMA
#undef PG8_WAIT_V
#undef PG8_WAIT_L
#undef PG8_BAR
#undef PG8_SCHED
}
}

#ifndef PG8_SP2
#define PG8_SP2 true
#endif
#ifndef PG8_ALIGN
#define PG8_ALIGN true
#endif
#include <hip/hip_bf16.h>
#include <cmath>
namespace attn_body {
using bf16=__hip_bfloat16;
using bf16x8=__attribute__((ext_vector_type(8)))short;
using s16x4=__attribute__((ext_vector_type(4)))short;
using f32x16=__attribute__((ext_vector_type(16)))float;
using u32x4=__attribute__((ext_vector_type(4)))unsigned;
constexpr int D=64,QP=512,KP=64;
constexpr int NW=8,QBLK=32,QB=QBLK*NW,KVBLK=64;
constexpr int ATTN_UNIT_ROWS=QB;
__device__ __forceinline__ int crow(int r,int hi){return (r&3)+8*(r>>2)+4*hi;}
#define SBAR() __builtin_amdgcn_sched_barrier(0)
__device__ __forceinline__ void cmask(f32x16&p0,f32x16&p1,int jb,int qrel,int hi){
  const float NEG=-INFINITY; int kb=64*jb+4*hi;
  #pragma unroll
  for(int r=0;r<16;++r){int kv=kb+(r&3)+8*(r>>2); if(kv>qrel)p0[r]=NEG; if(kv+32>qrel)p1[r]=NEG;}
}

constexpr int NSLOT=3, SLOTB=8192;
constexpr int LDS_K=0, LDS_V=NSLOT*SLOTB, LDS_WS=2*NSLOT*SLOTB, LDS_OST=LDS_WS+NW*64*4, LDS_BYTES=LDS_OST+NW*4096;
constexpr float C2=0.125f*1.4426950408889634f;
__device__ __forceinline__ void glds16(const void*gsrc,unsigned lds_dst){unsigned keep;
  asm volatile("s_mov_b32 %0, m0\n\ts_mov_b32 m0, %2\n\ts_nop 0\n\tglobal_load_lds_dwordx4 %1, off\n\ts_mov_b32 m0, %0":"=&s"(keep):"v"(gsrc),"s"(lds_dst):"memory");}
__device__ __forceinline__ float max3f(float a,float b,float c){float r;asm("v_max3_f32 %0, %1, %2, %3":"=v"(r):"v"(a),"v"(b),"v"(c));return r;}
__device__ __forceinline__ float max2f(float a,float b){float r;asm("v_max_f32_e32 %0, %1, %2":"=v"(r):"v"(a),"v"(b));return r;}
__device__ __forceinline__ float fadd_s(float a,float b){float r;asm("v_add_f32_e32 %0, %1, %2":"=v"(r):"v"(a),"v"(b));return r;}
__device__ __forceinline__ float fsub_s(float a,float b){float r;asm("v_sub_f32_e32 %0, %1, %2":"=v"(r):"v"(a),"v"(b));return r;}
typedef float f32x2_t __attribute__((ext_vector_type(2))); typedef __bf16 bf16x2_t __attribute__((ext_vector_type(2)));
__device__ __forceinline__ unsigned cvtpk_s(float lo,float hi){f32x2_t v={lo,hi};bf16x2_t b=__builtin_convertvector(v,bf16x2_t);return __builtin_bit_cast(unsigned,b);}
#define WAIT_BAR(N) asm volatile("s_waitcnt vmcnt(" #N ") lgkmcnt(0)\n\ts_barrier":::"memory")

__device__ __forceinline__ void qkt(f32x16&p0,f32x16&p1,const char*Kslot,const bf16x8*qr,const f32x16&negm,int r32,int hi){
  const char*kb=Kslot+hi*1024+r32*16;
  #pragma unroll
  for(int d0=0;d0<4;++d0){
    const bf16x8 b0=*reinterpret_cast<const bf16x8*>(kb+d0*2048);
    const bf16x8 b1=*reinterpret_cast<const bf16x8*>(kb+d0*2048+512);
    if(d0==0){p0=__builtin_amdgcn_mfma_f32_32x32x16_bf16(b0,qr[0],negm,0,0,0);p1=__builtin_amdgcn_mfma_f32_32x32x16_bf16(b1,qr[0],negm,0,0,0);}
    else{p0=__builtin_amdgcn_mfma_f32_32x32x16_bf16(b0,qr[d0],p0,0,0,0);p1=__builtin_amdgcn_mfma_f32_32x32x16_bf16(b1,qr[d0],p1,0,0,0);}}
}
typedef __attribute__((address_space(3))) const char* lds_cptr;
typedef short v4i16_t __attribute__((ext_vector_type(4)));
__device__ __forceinline__ void kload8(bf16x8*kf,lds_cptr kp){
  kf[0]=*(const __attribute__((address_space(3))) bf16x8*)(kp);      kf[1]=*(const __attribute__((address_space(3))) bf16x8*)(kp+512);
  kf[2]=*(const __attribute__((address_space(3))) bf16x8*)(kp+2048); kf[3]=*(const __attribute__((address_space(3))) bf16x8*)(kp+2560);
  kf[4]=*(const __attribute__((address_space(3))) bf16x8*)(kp+4096); kf[5]=*(const __attribute__((address_space(3))) bf16x8*)(kp+4608);
  kf[6]=*(const __attribute__((address_space(3))) bf16x8*)(kp+6144); kf[7]=*(const __attribute__((address_space(3))) bf16x8*)(kp+6656);
}
__device__ __forceinline__ void kload2(bf16x8*kf,lds_cptr kp,int j){ kf[2*j]=*(const __attribute__((address_space(3))) bf16x8*)(kp+j*2048); kf[2*j+1]=*(const __attribute__((address_space(3))) bf16x8*)(kp+j*2048+512); }
__device__ __forceinline__ s16x4 vtr(lds_cptr p){ return __builtin_bit_cast(s16x4,__builtin_amdgcn_ds_read_tr16_b64_v4i16((__attribute__((address_space(3))) v4i16_t*)p)); }
__device__ __forceinline__ float rowmax(const f32x16&p0,const f32x16&p1){
  float a=max3f(p0[0],p0[1],p1[0]),b=max3f(p0[2],p0[3],p1[1]);a=max3f(a,p1[2],p1[3]);
  #pragma unroll
  for(int r=4;r<16;r+=4){a=max3f(a,p0[r],p0[r+1]);b=max3f(b,p0[r+2],p0[r+3]);a=max3f(a,p1[r],p1[r+1]);b=max3f(b,p1[r+2],p1[r+3]);}
  const float m=max2f(a,b);
  auto rr=__builtin_amdgcn_permlane32_swap(__float_as_uint(m),__float_as_uint(m),false,false);
  return max2f(__uint_as_float(rr[0]),__uint_as_float(rr[1]));
}
__device__ __forceinline__ void pv(f32x16*o,int vb,bf16x8 pa0,bf16x8 pa1,bf16x8 pa2,bf16x8 pa3){
  #pragma unroll
  for(int d0=0;d0<2;++d0){s16x4 lo[4],hi[4];
    #pragma unroll
    for(int ks=0;ks<4;++ks){
      asm volatile("ds_read_b64_tr_b16 %0,%1 offset:%c2":"=&v"(lo[ks]):"v"(vb),"i"(d0*4096+ks*1024):"memory");
      asm volatile("ds_read_b64_tr_b16 %0,%1 offset:%c2":"=&v"(hi[ks]):"v"(vb),"i"(d0*4096+ks*1024+512):"memory");}
    asm volatile("s_waitcnt lgkmcnt(0)":::"memory");SBAR();
    #define PK(k) (bf16x8){lo[k][0],lo[k][1],lo[k][2],lo[k][3],hi[k][0],hi[k][1],hi[k][2],hi[k][3]}
    o[d0]=__builtin_amdgcn_mfma_f32_32x32x16_bf16(pa0,PK(0),o[d0],0,0,0);
    o[d0]=__builtin_amdgcn_mfma_f32_32x32x16_bf16(pa1,PK(1),o[d0],0,0,0);
    o[d0]=__builtin_amdgcn_mfma_f32_32x32x16_bf16(pa2,PK(2),o[d0],0,0,0);
    o[d0]=__builtin_amdgcn_mfma_f32_32x32x16_bf16(pa3,PK(3),o[d0],0,0,0);
    #undef PK
  }
}

#ifndef ATTN_STORE16
#define ATTN_STORE16(p,v) (*(u32x4*)(p)=(v))
#endif
template<int THRL> __device__ __forceinline__ void attn_unit(long qrow0,long kvrow0,int seq,int h,const bf16*Q,const bf16*__restrict__ K,const bf16*__restrict__ V,bf16*O,char*shm,long kvhstride,float mref){
  const int tid=threadIdx.x,lane=tid&63,r32=lane&31,hi=lane>>5; const int wid=__builtin_amdgcn_readfirstlane(tid>>6);
  const bf16*Qw=Q+(qrow0+wid*QBLK)*QP+h*D;
  const bf16*Kh=K+((long)(h>>2)*kvhstride+kvrow0)*KP,*Vh=V+((long)(h>>2)*kvhstride+kvrow0)*KP;
  const unsigned lds0=(unsigned)(uintptr_t)shm;
  float*wsf=(float*)(shm+LDS_WS)+wid*64;
  const bf16*ksrc=Kh+(long)lane*KP+wid*8;
  const bf16*vsrc=Vh+(long)(16*(wid&3)+(lane>>2))*KP+(wid>>2)*32+(lane&3)*8;
  const unsigned kdst=lds0+LDS_K+wid*1024, vdst=lds0+LDS_V+wid*1024;
  #define DMA_K(t,slot) glds16(ksrc+(long)(t)*KVBLK*KP,(unsigned)__builtin_amdgcn_readfirstlane(kdst+(slot)))
  #define DMA_V(t,slot) glds16(vsrc+(long)(t)*KVBLK*KP,(unsigned)__builtin_amdgcn_readfirstlane(vdst+(slot)))
  const int vb0=(int)(lds0+LDS_V)+((lane>>4)&1)*32+(lane&3)*8+(4*hi+((lane&15)>>2))*64;
  const char*Kbase=shm+LDS_K; bf16x8 kf[8];
  const lds_cptr shm3=(lds_cptr)shm; const lds_cptr kp0=shm3+LDS_K+hi*1024+r32*16; const lds_cptr vp0=shm3+LDS_V+((lane>>4)&1)*32+(lane&3)*8+(4*hi+((lane&15)>>2))*64;
  const int NT=seq/KVBLK;
  DMA_K(0,0);DMA_V(0,0);DMA_K(1,SLOTB);
  bf16x8 qr[4];
  #pragma unroll
  for(int d0=0;d0<4;++d0)qr[d0]=*reinterpret_cast<const bf16x8*>(&Qw[(long)r32*QP+d0*16+hi*8]);
  float l_reg=0.f;f32x16 o[2];o[0]=f32x16{};o[1]=f32x16{};f32x16 negm;
  #pragma unroll
  for(int r=0;r<16;++r)negm[r]=-mref;
  asm volatile("":"+v"(negm));
  #define CMASK(P0,P1,t) do{}while(0)
  bool resc=false;
  #define START(P0,P1) do{ resc=false; _Pragma("unroll") for(int r=0;r<16;++r)P0[r]=__builtin_amdgcn_exp2f(P0[r]); }while(0)
  #define RESC() do{ if(resc){ asm volatile("s_waitcnt lgkmcnt(0)":::"memory"); \
      _Pragma("unroll") for(int d_=0;d_<2;++d_) _Pragma("unroll") for(int r=0;r<16;++r)o[d_][r]*=wsf[crow(r,hi)]; } }while(0)
  f32x16 pA0,pA1,pB0,pB1;
  int sl_prev=0,sl_cur=0,sl_next=SLOTB;
  #define ROT() do{sl_prev=sl_cur;sl_cur=sl_next;sl_next=(sl_next==(NSLOT-1)*SLOTB)?0:sl_next+SLOTB;}while(0)
  DMA_K(2,2*SLOTB);
  WAIT_BAR(3);
  qkt(pA0,pA1,Kbase,qr,negm,r32,hi);asm volatile("s_nop 15\n\ts_nop 7":"+v"(pA0),"+v"(pA1));CMASK(pA0,pA1,0);
  START(pA0,pA1);
  _Pragma("unroll") for(int r=0;r<16;++r)pA1[r]=__builtin_amdgcn_exp2f(pA1[r]);
  WAIT_BAR(0);
  DMA_K(3,0);DMA_V(1,SLOTB);
  ROT();
  kload8(kf,kp0+sl_cur);
  WAIT_BAR(2);
  s16x4 vlo[8],vhi[8]; u32x4 pw0,pw1,pw2,pw3;
  #define PKW(P,B) cvtpk_s(P[B],P[B+1])
  #define PAF(k) __builtin_bit_cast(bf16x8,pw##k)
  #define VFR(i) (bf16x8){vlo[i][0],vlo[i][1],vlo[i][2],vlo[i][3],vhi[i][0],vhi[i][1],vhi[i][2],vhi[i][3]}
  #define PIN(x) asm volatile("":"+v"(x))
  #define MX3(a,b,c) __builtin_fmaxf(__builtin_fmaxf((a),(b)),(c))
  #define GAPA(MF,A0,A1,A2,A3,W0,W1,PW) do{ MF; sacc+=A0; sacc+=A1; sacc+=A2; sacc+=A3; PIN(sacc); W0; W1; PIN(PW); SBAR(); }while(0)
  #define EX(v) __builtin_amdgcn_exp2f(v)
  #define GAPB(MF,X,B) do{ MF; X[B]=EX(X[B]); X[B+1]=EX(X[B+1]); X[B+2]=EX(X[B+2]); X[B+3]=EX(X[B+3]); PIN(X); SBAR(); }while(0)
  #define VRD(i) do{ vlo[i]=vtr(vp_+(((i)>>2)*4096+((i)&3)*1024)); vhi[i]=vtr(vp_+(((i)>>2)*4096+((i)&3)*1024+512)); }while(0)
  #define KRD(G,j) do{ if(G){ kload2(kf,kp0+sl_next,j); SBAR(); } }while(0)
  #define STEP(C0,C1,P0,P1,t,GK,GV,GL) do{ SBAR(); \
    const lds_cptr vp_=vp0+sl_prev; \
    VRD(0); SBAR(); float sacc=(P0[0]+P0[1]); \
    GAPA(C0=__builtin_amdgcn_mfma_f32_32x32x16_bf16(kf[0],qr[0],negm,0,0,0), P0[2],P0[3],P0[4],P0[5],     pw0[0]=PKW(P0,0), pw0[1]=PKW(P0,2), pw0); \
    VRD(4); SBAR(); GAPA(C1=__builtin_amdgcn_mfma_f32_32x32x16_bf16(kf[1],qr[0],negm,0,0,0), P0[6],P0[7],P0[8],P0[9],     pw0[2]=PKW(P0,4), pw0[3]=PKW(P0,6), pw0); \
    VRD(1); SBAR(); GAPA(C0=__builtin_amdgcn_mfma_f32_32x32x16_bf16(kf[2],qr[1],C0,0,0,0),   P0[10],P0[11],P0[12],P0[13], pw1[0]=PKW(P0,8), pw1[1]=PKW(P0,10), pw1); \
    VRD(5); SBAR(); GAPA(C1=__builtin_amdgcn_mfma_f32_32x32x16_bf16(kf[3],qr[1],C1,0,0,0),   P0[14],P0[15],P1[0],P1[1],   pw1[2]=PKW(P0,12),pw1[3]=PKW(P0,14), pw1); \
    VRD(2); SBAR(); GAPA(C0=__builtin_amdgcn_mfma_f32_32x32x16_bf16(kf[4],qr[2],C0,0,0,0),   P1[2],P1[3],P1[4],P1[5],     pw2[0]=PKW(P1,0), pw2[1]=PKW(P1,2), pw2); \
    VRD(6); SBAR(); GAPA(C1=__builtin_amdgcn_mfma_f32_32x32x16_bf16(kf[5],qr[2],C1,0,0,0),   P1[6],P1[7],P1[8],P1[9],     pw2[2]=PKW(P1,4), pw2[3]=PKW(P1,6), pw2); \
    VRD(3); SBAR(); GAPA(C0=__builtin_amdgcn_mfma_f32_32x32x16_bf16(kf[6],qr[3],C0,0,0,0),   P1[10],P1[11],P1[12],P1[13], pw3[0]=PKW(P1,8), pw3[1]=PKW(P1,10), pw3); \
    VRD(7); SBAR(); GAPA(C1=__builtin_amdgcn_mfma_f32_32x32x16_bf16(kf[7],qr[3],C1,0,0,0),   P1[14],P1[15],0.f,0.f,       pw3[2]=PKW(P1,12),pw3[3]=PKW(P1,14), pw3); \
    l_reg+=sacc; \
    if(GK){DMA_K((t)+3,sl_cur);} if(GV){DMA_V((t)+1,sl_next);} \
    CMASK(C0,C1,t); \
    resc=false;   \
    SBAR(); \
    GAPB(o[0]=__builtin_amdgcn_mfma_f32_32x32x16_bf16(PAF(0),VFR(0),o[0],0,0,0), C0,0); \
    GAPB(o[1]=__builtin_amdgcn_mfma_f32_32x32x16_bf16(PAF(0),VFR(4),o[1],0,0,0), C0,4); \
    KRD(GL,0); GAPB(o[0]=__builtin_amdgcn_mfma_f32_32x32x16_bf16(PAF(1),VFR(1),o[0],0,0,0), C0,8); \
    KRD(GL,1); GAPB(o[1]=__builtin_amdgcn_mfma_f32_32x32x16_bf16(PAF(1),VFR(5),o[1],0,0,0), C0,12); \
    KRD(GL,2); GAPB(o[0]=__builtin_amdgcn_mfma_f32_32x32x16_bf16(PAF(2),VFR(2),o[0],0,0,0), C1,0); \
    KRD(GL,3); GAPB(o[1]=__builtin_amdgcn_mfma_f32_32x32x16_bf16(PAF(2),VFR(6),o[1],0,0,0), C1,4); \
    GAPB(o[0]=__builtin_amdgcn_mfma_f32_32x32x16_bf16(PAF(3),VFR(3),o[0],0,0,0), C1,8); \
    GAPB(o[1]=__builtin_amdgcn_mfma_f32_32x32x16_bf16(PAF(3),VFR(7),o[1],0,0,0), C1,12); \
    }while(0)
  int t=1;
  #undef CMASK
  #define CMASK(P0,P1,t) do{}while(0)
  for(;t+5<NT;t+=2){
    STEP(pB0,pB1,pA0,pA1,t,true,true,true);     WAIT_BAR(2); RESC(); ROT();
    STEP(pA0,pA1,pB0,pB1,t+1,true,true,true);   WAIT_BAR(2); RESC(); ROT();
  }
  #undef CMASK
  #define CMASK(P0,P1,t) do{}while(0)
  #define ENDW(tt) do{ if((tt)+3<NT){WAIT_BAR(2);} else if((tt)+2<NT){WAIT_BAR(1);} else {WAIT_BAR(0);} }while(0)
  for(;t+1<NT;t+=2){
    STEP(pB0,pB1,pA0,pA1,t,(t+3<NT),(t+1<NT),(t+1<NT));       ENDW(t);   RESC(); ROT();
    STEP(pA0,pA1,pB0,pB1,t+1,(t+4<NT),(t+2<NT),(t+2<NT));     ENDW(t+1); RESC(); ROT();
  }
  STEP(pB0,pB1,pA0,pA1,NT-1,false,false,false); RESC();
  { float sacc=pB0[0]+pB0[1]; _Pragma("unroll") for(int r=2;r<16;++r)sacc+=pB0[r]; _Pragma("unroll") for(int r=0;r<16;++r)sacc+=pB1[r]; l_reg+=sacc;
    pw0=(u32x4){PKW(pB0,0),PKW(pB0,2),PKW(pB0,4),PKW(pB0,6)};pw1=(u32x4){PKW(pB0,8),PKW(pB0,10),PKW(pB0,12),PKW(pB0,14)};pw2=(u32x4){PKW(pB1,0),PKW(pB1,2),PKW(pB1,4),PKW(pB1,6)};pw3=(u32x4){PKW(pB1,8),PKW(pB1,10),PKW(pB1,12),PKW(pB1,14)};
    SBAR(); pv(o,vb0+sl_cur,PAF(0),PAF(1),PAF(2),PAF(3)); }
  #undef PKW
  #undef PAF
  #undef VFR
  #undef PIN
  #undef MX3
  #undef GAPA
  #undef GAPB
  #undef EX
  #undef VRD
  #undef KRD
  #undef STEP
  #undef ENDW
  {auto rr=__builtin_amdgcn_permlane32_swap(__float_as_uint(l_reg),__float_as_uint(l_reg),false,false);l_reg=__uint_as_float(rr[0])+__uint_as_float(rr[1]);}
  if(hi==0)wsf[32+r32]=l_reg;asm volatile("s_waitcnt lgkmcnt(0)":::"memory");
  float rli[16];
  #pragma unroll
  for(int r=0;r<16;++r)rli[r]=__builtin_amdgcn_rcpf(wsf[32+crow(r,hi)]);
  bf16*Ow=O+(qrow0+wid*QBLK)*QP+h*D;
  { bf16*stg=(bf16*)(shm+LDS_OST)+wid*2048;
    #pragma unroll
    for(int r=0;r<16;++r){const int orow=crow(r,hi);
      #pragma unroll
      for(int d0=0;d0<2;++d0)stg[orow*64+d0*32+r32]=__float2bfloat16(o[d0][r]*rli[r]);}
    asm volatile("s_waitcnt lgkmcnt(0)":::"memory");
    #pragma unroll
    for(int i=0;i<4;++i){const int row=i*8+(lane>>3),ch=lane&7; const u32x4 v=*(const u32x4*)(stg+row*64+ch*8); ATTN_STORE16(Ow+(long)row*QP+ch*8,v);} }
  asm volatile("s_waitcnt lgkmcnt(0)\n\ts_barrier":::"memory");
  #undef DMA_K
  #undef DMA_V
  #undef CMASK
  #undef START
  #undef RESC
  #undef ROT
}
constexpr int ATTN_LDS_BYTES=LDS_BYTES;
#undef SBAR
#undef WAIT_BAR
}
constexpr int NWAVES = 8;
constexpr int DM = 1024, LP = 2048, LS = 8192, NBP = 16, NBS = 8;
constexpr int TOKP = NBP * LP, TOKS = NBS * LS, TT = TOKP + TOKS;
constexpr int HYW = 512, INC = 2304, DFF = 2816, QW = 512;
constexpr float EPS = 1e-6f;
constexpr float QSCALE = 0.125f * 1.4426950408889634f;
constexpr size_t MiB = 1u << 20;
constexpr size_t WS_CTL = 0, CTL_ZERO_BYTES = 1 * MiB;
constexpr size_t WS_ROWSQ1 = 0, WS_ROWSQ2 = 512 * 1024, WS_BAR = 900 * 1024, WS_QCTR = 1000 * 1024;
constexpr size_t WS_WIN = 2 * MiB, WS_WOUT = 7 * MiB, WS_WGU = 9 * MiB, WS_WD = 20 * MiB;
constexpr size_t WS_HRAW = 26 * MiB;
constexpr size_t WS_TAB = 66 * MiB;
constexpr size_t WS_A = 128 * MiB;
constexpr size_t WS_YT = WS_A, WS_MIX = WS_A + 96 * MiB, WS_O = WS_A + 288 * MiB;
constexpr size_t WS_B = 656 * MiB;
constexpr size_t WS_ZT = WS_B, WS_X0T = WS_B + 96 * MiB;
constexpr size_t WS_Q = 848 * MiB;
constexpr size_t WS_K = 944 * MiB, WS_V = 968 * MiB;
constexpr size_t WS_END = 992 * MiB;
static_assert(WS_WIN + (size_t)INC * DM * 2 <= WS_WOUT && WS_WGU + (size_t)2 * DFF * DM * 2 <= WS_WD && WS_WD + (size_t)DM * DFF * 2 <= WS_HRAW, "weights map");
static_assert(WS_A + (size_t)TT * DFF * 2 <= WS_B && WS_A + (size_t)TT * INC * 2 <= WS_B && WS_B + (size_t)TT * DM * 2 <= WS_Q && WS_Q + (size_t)TT * QW * 2 <= WS_K, "activation map");
constexpr int RING_BYTES = 131072;
constexpr int LDSCTL_OFF = RING_BYTES, ZERO_OFF = LDSCTL_OFF + 64;
constexpr int LDS_BYTES = 147456, BARST_OFF = LDS_BYTES - 64;

#define GAS __attribute__((address_space(1)))
#define LAS __attribute__((address_space(3)))
typedef unsigned short bf16;
typedef unsigned v4u __attribute__((ext_vector_type(4)));
typedef unsigned v2u __attribute__((ext_vector_type(2)));
typedef float f32x4 __attribute__((ext_vector_type(4)));
typedef float f32x16 __attribute__((ext_vector_type(16)));
typedef short s16x8 __attribute__((ext_vector_type(8)));
#define LDS_WAIT() asm volatile("s_waitcnt lgkmcnt(0)" ::: "memory")
__device__ __forceinline__ unsigned f2bf(float f) { unsigned u = __builtin_bit_cast(unsigned, f); return (u + 0x7fffu + ((u >> 16) & 1u)) >> 16; }
__device__ __forceinline__ unsigned pk2(float lo, float hi) { return f2bf(lo) | (f2bf(hi) << 16); }
__device__ __forceinline__ float bflo(unsigned w) { return __builtin_bit_cast(float, w << 16); }
__device__ __forceinline__ float bfhi(unsigned w) { return __builtin_bit_cast(float, w & 0xffff0000u); }
__device__ __forceinline__ float wave_sum(float v) {
#pragma unroll
    for (int o = 1; o < 64; o <<= 1) v += __shfl_xor(v, o);
    return v;
}
__device__ __forceinline__ float half_sum(float v) {
#pragma unroll
    for (int o = 1; o < 32; o <<= 1) v += __shfl_xor(v, o);
    return v;
}
__device__ __forceinline__ float rdlane(float v, int l) { return __builtin_bit_cast(float, __builtin_amdgcn_readlane(__builtin_bit_cast(int, v), l)); }
template <int CTRL> __device__ __forceinline__ float dpp_f(float v) { return __builtin_bit_cast(float, __builtin_amdgcn_update_dpp(0, __builtin_bit_cast(int, v), CTRL, 0xF, 0xF, true)); }
__device__ __forceinline__ float oct_sum(float v) { v += dpp_f<0xB1>(v); v += dpp_f<0x4E>(v); v += dpp_f<0x141>(v); return v; }
__device__ __forceinline__ float sin_rev(float rev) { return __builtin_amdgcn_sinf(__builtin_amdgcn_fractf(rev)); }
__device__ __forceinline__ float cos_rev(float rev) { return __builtin_amdgcn_cosf(__builtin_amdgcn_fractf(rev)); }
__device__ __forceinline__ float sin_rad(float x) { return sin_rev(x * 0.15915494309189535f); }

#define XB_TMO      128
#define XB_XCNT(j)  (256  + 64 * (j))
#define XB_XSUB(j)  (1280 + 64 * (j))
#define XB_XGEN(j)  (2304 + 64 * (j))
#define XB_TOP      3328
#define XB_TOPGEN   3392
#define XCD_BAR_WORDS 3456
#define XB_SPIN_CAP (1u << 18)

__device__ __forceinline__ unsigned xb_ld(unsigned* p)              { return __hip_atomic_load(p, __ATOMIC_RELAXED, __HIP_MEMORY_SCOPE_AGENT); }
__device__ __forceinline__ unsigned xb_add(unsigned* p, unsigned v) { return __hip_atomic_fetch_add(p, v, __ATOMIC_RELAXED, __HIP_MEMORY_SCOPE_AGENT); }
__device__ __forceinline__ unsigned xb_xcc_id() { return (unsigned)__builtin_amdgcn_s_getreg((3 << 11) | 20) & 0xFu; }
#define XB_SPIN(cond, bar) do { unsigned _sp = 0; while (cond) { __builtin_amdgcn_s_sleep(1); \
    if ((++_sp & 255u) == 0u) { if (xb_ld(&(bar)[XB_TMO])) break; if (_sp > XB_SPIN_CAP) { atomicAdd(&(bar)[XB_TMO], 1u); break; } } } } while (0)

struct XcdBarrier {
    unsigned* bar; unsigned x;
    volatile LAS unsigned* st;
};

__device__ __forceinline__ XcdBarrier xcd_barrier_post(unsigned* bar, volatile LAS unsigned* st) {
    XcdBarrier b; b.bar = bar; b.x = xb_xcc_id(); b.st = st;
    if (threadIdx.x == 0) (void)xb_add(&bar[XB_XCNT(b.x)], 1u);
    return b;
}
__device__ __forceinline__ void xcd_barrier_complete(unsigned* bar, unsigned x, unsigned& nloc, unsigned& nx) {
    const unsigned G = gridDim.x * gridDim.y * gridDim.z;
    unsigned sum, cnt, mine, sp = 0u;
    for (;;) {
        sum = 0u; cnt = 0u; mine = 0u;
#pragma unroll
        for (unsigned j = 0; j < 16; ++j) { const unsigned c = xb_ld(&bar[XB_XCNT(j)]); sum += c; cnt += (c > 0u) ? 1u : 0u; mine = (j == x) ? c : mine; }
        if (sum == G) break;
        __builtin_amdgcn_s_sleep(1);
        if ((++sp & 255u) == 0u) { if (xb_ld(&bar[XB_TMO])) break; if (sp > XB_SPIN_CAP) { atomicAdd(&bar[XB_TMO], 1u); break; } }
    }
    nloc = mine > 0u ? mine : 1u; nx = cnt > 0u ? cnt : 1u;
}

__device__ __forceinline__ void xcd_barrier(const XcdBarrier& b) {
    asm volatile("s_waitcnt vmcnt(0)" ::: "memory");
    __syncthreads();
    if (threadIdx.x == 0) {
        unsigned* bar = b.bar;
        __builtin_amdgcn_s_waitcnt(0);
        unsigned nloc = b.st[0], nx = b.st[1];
        if (nloc == 0u) { xcd_barrier_complete(bar, b.x, nloc, nx); b.st[0] = nloc; b.st[1] = nx; }
        const unsigned old = xb_add(&bar[XB_XSUB(b.x)], 1u);
        const unsigned gen = old / nloc;
        if (old + 1u == (gen + 1u) * nloc) {
            __builtin_amdgcn_fence(__ATOMIC_RELEASE, "agent");
            asm volatile("s_waitcnt vmcnt(0)" ::: "memory");
            const unsigned og = xb_add(&bar[XB_TOP], 1u);
            const unsigned tg = og / nx;
            if (og + 1u == (tg + 1u) * nx) xb_add(&bar[XB_TOPGEN], 1u);
            else XB_SPIN(xb_ld(&bar[XB_TOPGEN]) == tg, bar);
            __builtin_amdgcn_fence(__ATOMIC_ACQUIRE, "agent");
            xb_add(&bar[XB_XGEN(b.x)], 1u);
            asm volatile("s_waitcnt vmcnt(0)" ::: "memory");
        } else {
            XB_SPIN(xb_ld(&bar[XB_XGEN(b.x)]) == gen, bar);
            __builtin_amdgcn_fence(__ATOMIC_ACQUIRE, "agent");
            asm volatile("s_waitcnt vmcnt(0)" ::: "memory");
        }
    }
    __syncthreads();
}

typedef const float* cfp;
struct Frame {
    LAS unsigned char* lds;
    int tid, lane, wave, vcu, G;
    const __attribute__((address_space(4))) cfp* in;
    float* out; unsigned char* ws;
};

__device__ __forceinline__ void p0_transpose_item(const float* W, int K, int N, bf16* WT, int mode, const float* kscale, LAS float* scr, int item, int lane) {
    const int nblk = N / 32, kb = item / nblk, nb = item % nblk, k0 = 64 * kb, n0 = 32 * nb;
#pragma unroll 8
    for (int i = 0; i < 32; ++i) { const int kk = 2 * i + (lane >> 5); float v = W[(size_t)(k0 + kk) * N + n0 + (lane & 31)]; if (kscale) v *= kscale[k0 + kk]; scr[kk * 33 + (lane & 31)] = v; }
    LDS_WAIT(); asm volatile("" ::: "memory");
    const int c = lane & 7;
    const int rbase = (mode == 0) ? n0 : ((n0 >> 7) * 256 + (n0 & 127) + (mode == 2 ? 128 : 0));
#pragma unroll
    for (int j = 0; j < 4; ++j) { const int n = (lane >> 3) + 8 * j; const LAS float* s = scr + (8 * c) * 33 + n;
        v4u o; o.x = pk2(s[0 * 33], s[1 * 33]); o.y = pk2(s[2 * 33], s[3 * 33]); o.z = pk2(s[4 * 33], s[5 * 33]); o.w = pk2(s[6 * 33], s[7 * 33]);
        *(GAS v4u*)(WT + (size_t)(rbase + n) * K + k0 + 8 * c) = o; }
    LDS_WAIT(); asm volatile("" ::: "memory");
}
__device__ __forceinline__ void rms_rows4_to_bf16(const float* xrow, const float* g, bf16* orow, int lane) {
    f32x4 v[4][4]; float s[4];
#pragma unroll
    for (int i = 0; i < 4; ++i) { const GAS f32x4* xr = (const GAS f32x4*)(xrow + (size_t)i * DM) + lane; s[i] = 0.f;
#pragma unroll
        for (int j = 0; j < 4; ++j) v[i][j] = xr[64 * j]; }
#pragma unroll
    for (int i = 0; i < 4; ++i) {
#pragma unroll
        for (int j = 0; j < 4; ++j) s[i] += (v[i][j].x * v[i][j].x + v[i][j].y * v[i][j].y) + (v[i][j].z * v[i][j].z + v[i][j].w * v[i][j].w);
        s[i] = 1.0f / sqrtf(wave_sum(s[i]) * (1.f / DM) + EPS); }
    const GAS f32x4* gr = (const GAS f32x4*)g + lane;
#pragma unroll
    for (int j = 0; j < 4; ++j) { const f32x4 gg = gr[64 * j];
#pragma unroll
        for (int i = 0; i < 4; ++i) { GAS unsigned long long* o8 = (GAS unsigned long long*)(orow + (size_t)i * DM) + lane; const float rs = s[i];
            o8[64 * j] = (unsigned long long)pk2(v[i][j].x * rs * gg.x, v[i][j].y * rs * gg.y) | ((unsigned long long)pk2(v[i][j].z * rs * gg.z, v[i][j].w * rs * gg.w) << 32); } }
}
__device__ __forceinline__ void p0_filter_group(const Frame& F, int grp) {
    const int seg = grp < (LP / 8) ? 0 : 1, L = seg ? LS : LP, t0 = (seg ? grp - LP / 8 : grp) * 8, lane = F.lane;
    float* hraw = (float*)(F.ws + WS_HRAW) + (seg ? (size_t)1024 * LP : 0);
    const float fr = F.in[11][lane], b1 = F.in[7][lane], b2 = F.in[9][lane];
    const float invL = 1.0f / (float)L, invLm1 = 1.0f / (float)(L - 1);
    float h2[8];
    {
        float pre[8], h1[8];
        const float w10 = F.in[6][lane];
#pragma unroll
        for (int ti = 0; ti < 8; ++ti) pre[ti] = b1 + ((float)(t0 + ti) * invLm1) * w10;
#pragma unroll 4
        for (int j = 0; j < 16; ++j) {
            const float wc = F.in[6][(1 + j) * 64 + lane], wsn = F.in[6][(17 + j) * 64 + lane];
            const float bandL = (1e-4f + (float)j * ((15.0f - 1e-4f) / 15.0f)) * invL;
#pragma unroll
            for (int ti = 0; ti < 8; ++ti) { const float rev = (float)(t0 + ti) * bandL; pre[ti] += cos_rev(rev) * wc - sin_rev(rev) * wsn; }
        }
#pragma unroll
        for (int ti = 0; ti < 8; ++ti) { h1[ti] = sin_rad(fr * pre[ti]); pre[ti] = b2; }
#pragma unroll 8
        for (int k = 0; k < 64; ++k) {
            const float w = F.in[8][k * 64 + lane];
#pragma unroll
            for (int ti = 0; ti < 8; ++ti) pre[ti] += rdlane(h1[ti], k) * w;
        }
#pragma unroll
        for (int ti = 0; ti < 8; ++ti) h2[ti] = sin_rad(fr * pre[ti]);
    }
    {
        float acc[8][16];
#pragma unroll
        for (int ti = 0; ti < 8; ++ti)
#pragma unroll
            for (int q = 0; q < 16; ++q) acc[ti][q] = 0.f;
#pragma unroll 2
        for (int k = 0; k < 64; ++k) {
            const GAS f32x4* wr = (const GAS f32x4*)(F.in[10] + (size_t)k * 1024 + lane * 16);
            const f32x4 w0 = wr[0], w1 = wr[1], w2 = wr[2], w3 = wr[3];
#pragma unroll
            for (int ti = 0; ti < 8; ++ti) { const float hv = rdlane(h2[ti], k);
#pragma unroll
                for (int q = 0; q < 4; ++q) { acc[ti][q] += hv * w0[q]; acc[ti][4 + q] += hv * w1[q]; acc[ti][8 + q] += hv * w2[q]; acc[ti][12 + q] += hv * w3[q]; } }
        }
#pragma unroll
        for (int q = 0; q < 16; ++q) {
            const int o = lane * 16 + q;
            const float dec = fabsf(F.in[12][o]) * 1.4426950408889634f;
            f32x4 v0, v1;
#pragma unroll
            for (int ti = 0; ti < 4; ++ti) { v0[ti] = acc[ti][q] * __builtin_amdgcn_exp2f(-((float)(t0 + ti) * invLm1) * dec); v1[ti] = acc[4 + ti][q] * __builtin_amdgcn_exp2f(-((float)(t0 + 4 + ti) * invLm1) * dec); }
            GAS f32x4* dst = (GAS f32x4*)(hraw + (size_t)o * L + t0);
            dst[0] = v0; dst[1] = v1;
        }
    }
}
__device__ __forceinline__ void p0_prologue(const Frame& F) {
    LAS float* scr = (LAS float*)(F.lds + F.wave * 16384);
    const int gw = F.vcu * NWAVES + F.wave, NGW = F.G * NWAVES;
    bf16* Win_t = (bf16*)(F.ws + WS_WIN); bf16* Wout_t = (bf16*)(F.ws + WS_WOUT); bf16* Wgu_t = (bf16*)(F.ws + WS_WGU); bf16* Wd_t = (bf16*)(F.ws + WS_WD);
    constexpr int I_IN = (DM / 64) * (INC / 32), I_OUT = (DM / 64) * (DM / 32), I_G = (DM / 64) * (DFF / 32), I_D = (DFF / 64) * (DM / 32);
    constexpr int NITEMS = I_IN + I_OUT + 2 * I_G + I_D;
    if (F.wave < 5) for (int g = F.vcu * 5 + F.wave; g < (LP + LS) / 8; g += F.G * 5) p0_filter_group(F, g);
    for (int it = gw; it < NITEMS; it += NGW) {
        int r = it;
        if (r < I_IN) { p0_transpose_item(F.in[3], DM, INC, Win_t, 0, nullptr, scr, r, F.lane); continue; } r -= I_IN;
        if (r < I_OUT) { p0_transpose_item(F.in[18], DM, DM, Wout_t, 0, nullptr, scr, r, F.lane); continue; } r -= I_OUT;
        if (r < I_G) { p0_transpose_item(F.in[20], DM, DFF, Wgu_t, 1, F.in[19], scr, r, F.lane); continue; } r -= I_G;
        if (r < I_G) { p0_transpose_item(F.in[21], DM, DFF, Wgu_t, 2, F.in[19], scr, r, F.lane); continue; } r -= I_G;
        p0_transpose_item(F.in[22], DFF, DM, Wd_t, 0, nullptr, scr, r, F.lane);
    }
    bf16* hb = (bf16*)(F.ws + WS_B);
    for (int m = gw * 4; m < TT; m += NGW * 4) rms_rows4_to_bf16(m < TOKP ? F.in[0] + (size_t)m * DM : F.in[1] + (size_t)(m - TOKP) * DM, F.in[2], hb + (size_t)m * DM, F.lane);
}
__device__ __forceinline__ void seq_of(int m, int& s0, int& L) { if (m < TOKP) { L = LP; s0 = m & ~(LP - 1); } else { L = LS; s0 = TOKP + ((m - TOKP) & ~(LS - 1)); } }
__device__ __forceinline__ void p2_conv_task(const Frame& F, int tt, int cgp) {
    const bf16* proj = (const bf16*)(F.ws + WS_A); bf16* zT = (bf16*)(F.ws + WS_ZT); bf16* x0T = (bf16*)(F.ws + WS_X0T);
    const int m0 = tt * 64; int s0, L; seq_of(m0, s0, L);
    const int cp = F.lane & 31, th = F.lane >> 5, c = cgp * 64 + 2 * cp, tl0 = m0 - s0 + 32 * th;
    float w[3][3][2], bs[3][2];
#pragma unroll
    for (int g = 0; g < 3; ++g)
#pragma unroll
        for (int k = 0; k < 2; ++k) { bs[g][k] = F.in[5][g * 512 + c + k];
#pragma unroll
            for (int j = 0; j < 3; ++j) w[g][j][k] = F.in[4][j * 1536 + g * 512 + c + k]; }
    unsigned zA[16], zB[16], xA[16], xB[16];
#pragma unroll
    for (int hh = 0; hh < 2; ++hh) {
        unsigned uu[18][3];
#pragma unroll
        for (int r = 0; r < 18; ++r) { const int t = tl0 + 16 * hh + r - 1; const int tcl = t < 0 ? 0 : (t >= L ? L - 1 : t); const bf16* p = proj + (size_t)(s0 + tcl) * INC + c;
            const bool ok = (t >= 0) && (t < L); const unsigned a0 = *(const unsigned*)p, a1 = *(const unsigned*)(p + 512), a2 = *(const unsigned*)(p + 1024);
            uu[r][0] = ok ? a0 : 0u; uu[r][1] = ok ? a1 : 0u; uu[r][2] = ok ? a2 : 0u; }
#pragma unroll
        for (int r = 0; r < 16; ++r) {
            float uc[3][2];
#pragma unroll
            for (int g = 0; g < 3; ++g) {
                uc[g][0] = bs[g][0] + w[g][0][0] * bflo(uu[r][g]) + w[g][1][0] * bflo(uu[r + 1][g]) + w[g][2][0] * bflo(uu[r + 2][g]);
                uc[g][1] = bs[g][1] + w[g][0][1] * bfhi(uu[r][g]) + w[g][1][1] * bfhi(uu[r + 1][g]) + w[g][2][1] * bfhi(uu[r + 2][g]);
            }
            const unsigned za = f2bf(uc[1][0] * uc[2][0]), zb = f2bf(uc[1][1] * uc[2][1]), xa = f2bf(uc[0][0]), xb = f2bf(uc[0][1]);
            const int q = 8 * hh + (r >> 1);
            if (r & 1) { zA[q] |= za << 16; zB[q] |= zb << 16; xA[q] |= xa << 16; xB[q] |= xb << 16; }
            else { zA[q] = za; zB[q] = zb; xA[q] = xa; xB[q] = xb; }
        }
    }
    const size_t o = (size_t)s0 * 512 + (size_t)c * L + tl0;
#pragma unroll
    for (int i = 0; i < 4; ++i) {
        *(GAS v4u*)(zT + o + 8 * i) = (v4u){zA[4 * i], zA[4 * i + 1], zA[4 * i + 2], zA[4 * i + 3]};
        *(GAS v4u*)(zT + o + L + 8 * i) = (v4u){zB[4 * i], zB[4 * i + 1], zB[4 * i + 2], zB[4 * i + 3]};
        *(GAS v4u*)(x0T + o + 8 * i) = (v4u){xA[4 * i], xA[4 * i + 1], xA[4 * i + 2], xA[4 * i + 3]};
        *(GAS v4u*)(x0T + o + L + 8 * i) = (v4u){xB[4 * i], xB[4 * i + 1], xB[4 * i + 2], xB[4 * i + 3]};
    }
}
__device__ __forceinline__ void p2_qkv_task(const Frame& F, int tt) {
    const bf16* proj = (const bf16*)(F.ws + WS_A); bf16* qn = (bf16*)(F.ws + WS_Q); bf16* kn = (bf16*)(F.ws + WS_K); bf16* vb = (bf16*)(F.ws + WS_V);
    const int i8 = F.lane & 7, tk = F.lane >> 3;
    float inv[4];
#pragma unroll
    for (int q = 0; q < 4; ++q) inv[q] = __builtin_amdgcn_exp2f(-(float)((4 * i8 + q) & 15) * (13.287712379549449f / 16.0f)) * 0.15915494309189535f;
    const f32x4 gq0 = *(const GAS f32x4*)(F.in[14] + 8 * i8), gq1 = *(const GAS f32x4*)(F.in[14] + 8 * i8 + 4), gk0 = *(const GAS f32x4*)(F.in[15] + 8 * i8), gk1 = *(const GAS f32x4*)(F.in[15] + 8 * i8 + 4);
#pragma unroll 1
    for (int it = 0; it < 4; ++it) {
        const int m = tt * 32 + 8 * it + tk; int s0, L; seq_of(m, s0, L);
        const int t = m - s0; const float pos = (float)((i8 < 4) ? (t >> 6) : (t & 63));
        const bf16* row = proj + (size_t)m * INC;
        v4u hv[10], vv[2];
#pragma unroll
        for (int h = 0; h < 10; ++h) hv[h] = *(const GAS v4u*)(row + 1536 + h * 64 + 8 * i8);
#pragma unroll
        for (int h = 0; h < 2; ++h) vv[h] = *(const GAS v4u*)(row + 2176 + h * 64 + 8 * i8);
        float cs[4], sn[4];
#pragma unroll
        for (int q = 0; q < 4; ++q) { const float rev = pos * inv[q]; cs[q] = cos_rev(rev); sn[q] = sin_rev(rev); }
#pragma unroll
        for (int h = 0; h < 10; ++h) {
            float f[8] = {bflo(hv[h].x), bfhi(hv[h].x), bflo(hv[h].y), bfhi(hv[h].y), bflo(hv[h].z), bfhi(hv[h].z), bflo(hv[h].w), bfhi(hv[h].w)};
            float ss = 0.f;
#pragma unroll
            for (int q = 0; q < 8; ++q) ss += f[q] * f[q];
            const float rstd = (1.0f / sqrtf(oct_sum(ss) * (1.0f / 64.0f) + EPS)) * (h < 8 ? QSCALE : 1.0f);
            const f32x4 g0 = h < 8 ? gq0 : gk0, g1 = h < 8 ? gq1 : gk1;
            f[0] *= rstd * g0.x; f[1] *= rstd * g0.y; f[2] *= rstd * g0.z; f[3] *= rstd * g0.w; f[4] *= rstd * g1.x; f[5] *= rstd * g1.y; f[6] *= rstd * g1.z; f[7] *= rstd * g1.w;
            unsigned w[4];
#pragma unroll
            for (int q = 0; q < 4; ++q) w[q] = pk2(f[2 * q] * cs[q] - f[2 * q + 1] * sn[q], f[2 * q] * sn[q] + f[2 * q + 1] * cs[q]);
            if (h < 8) *(GAS v4u*)(qn + (size_t)m * QW + h * 64 + 8 * i8) = (v4u){w[0], w[1], w[2], w[3]};
            else *(GAS v4u*)(kn + ((size_t)(h - 8) * TT + m) * 64 + 8 * i8) = (v4u){w[0], w[1], w[2], w[3]};
        }
#pragma unroll
        for (int h = 0; h < 2; ++h) *(GAS v4u*)(vb + ((size_t)h * TT + m) * 64 + 8 * i8) = vv[h];
    }
}
__device__ __forceinline__ void p2_table_task(const Frame& F, int id) {
    const int seg = id >> 9, c = id & 511, L = seg ? LS : LP, lane = F.lane;
    const float* hraw = (const float*)(F.ws + WS_HRAW) + (seg ? (size_t)1024 * LP : 0);
    const float* hf = hraw + (size_t)c * L; const float* hbk = hraw + (size_t)(512 + c) * L;
    float s = 0.f;
#pragma unroll 8
    for (int i = lane * 4; i < L; i += 256) { const f32x4 a = *(const GAS f32x4*)(hf + i), b = *(const GAS f32x4*)(hbk + i);
        s += (fabsf(a.x) + fabsf(a.y)) + (fabsf(a.z) + fabsf(a.w)) + (i == 0 ? 0.f : fabsf(b.x)) + fabsf(b.y) + (fabsf(b.z) + fabsf(b.w)); }
    const float inv = 1.0f / wave_sum(s);
    bf16* T0 = (bf16*)(F.ws + WS_TAB) + (seg ? (size_t)512 * 2 * 2 * LP : 0) + (size_t)c * 4 * L; bf16* T1 = T0 + 2 * L;
    const int boff = 512 * L - L;
#pragma unroll 4
    for (int x0 = lane * 8; x0 < 2 * L; x0 += 512) {
        float v[9];
#pragma unroll
        for (int j = 0; j < 9; ++j) { const int x = x0 + j; const int xi = x >= 2 * L ? 2 * L - 1 : x; const float t = hf[xi <= L ? L - xi : boff + xi]; v[j] = (x == 0 || x >= 2 * L) ? 0.f : t * inv; }
        *(GAS v4u*)(T0 + x0) = (v4u){pk2(v[0], v[1]), pk2(v[2], v[3]), pk2(v[4], v[5]), pk2(v[6], v[7])};
        *(GAS v4u*)(T1 + x0) = (v4u){pk2(v[1], v[2]), pk2(v[3], v[4]), pk2(v[5], v[6]), pk2(v[7], v[8])};
    }
}
__device__ __forceinline__ void p2_phase(const Frame& F) {
    const int gw = F.vcu * NWAVES + F.wave, NGW = F.G * NWAVES;
    constexpr int N_CONV = (TT / 64) * 8, N_QKV = TT / 32, N_TAB = 0;
    for (int id = gw; id < N_CONV + N_QKV + N_TAB; id += NGW) {
        if (id < N_CONV) {
            int tt = id >> 3;
            if (NGW == 2048) {
                const int k = tt >> 8, t = tt & 255, x = t >> 5, j = (t >> 2) & 7, sub = t & 3;
                tt = 4 * (48 * x + 8 * (5 - k) + j) + sub;
            }
            p2_conv_task(F, tt, id & 7);
        }
        else if (id < N_CONV + N_QKV) p2_qkv_task(F, id - N_CONV);
        else p2_table_task(F, id - N_CONV - N_QKV);
    }
}
typedef unsigned v4u_a4 __attribute__((ext_vector_type(4), aligned(4)));
template <int NB> __device__ __forceinline__ int zaddr(int tc, int b) { return NB == 16 ? 256 * tc + 16 * b : 128 * tc + 16 * b; }
template <int TPW, int CB, int ZTOP, bool CLAMP>
__device__ __forceinline__ void hy_groups(int g0, int g1, LAS unsigned char* lds, f32x16 (&acc)[TPW], v4u (&a)[4], v4u (&bx)[TPW / 2], v4u (&by)[TPW / 2], int (&off)[4], const char*& pa, bool next_clamped) {
    constexpr int HT = TPW / 2;
#define HY_RD(dst, base, h, CL) do { _Pragma("unroll") for (int jj = 0; jj < HT; ++jj) { int ad = (base) + ((h) * HT + jj) * 2048; if (CL) ad = ad < 0 ? 0 : (ad > ZTOP ? ZTOP : ad); dst[jj] = *(const LAS v4u*)(lds + ad); } } while (0)
#define HY_MM(av, src, h) do { _Pragma("unroll") for (int jj = 0; jj < HT; ++jj) acc[(h) * HT + jj] = __builtin_amdgcn_mfma_f32_32x32x16_bf16(__builtin_bit_cast(s16x8, av), __builtin_bit_cast(s16x8, src[jj]), acc[(h) * HT + jj], 0, 0, 0); } while (0)
#define HY_SB() __builtin_amdgcn_sched_barrier(0)
    for (int g = g0; g < g1; ++g) {
        v4u an[4];
#pragma unroll
        for (int u = 0; u < 4; ++u) an[u] = *(const GAS v4u_a4*)(pa - 32 * u);
        pa -= 128;
        HY_SB();
        HY_RD(by, off[0], 1, CLAMP); HY_SB(); HY_MM(a[0], bx, 0); HY_SB(); HY_RD(bx, off[1], 0, CLAMP); HY_SB(); HY_MM(a[0], by, 1); HY_SB();
        HY_RD(by, off[1], 1, CLAMP); HY_SB(); HY_MM(a[1], bx, 0); HY_SB(); HY_RD(bx, off[2], 0, CLAMP); HY_SB(); HY_MM(a[1], by, 1); HY_SB();
        HY_RD(by, off[2], 1, CLAMP); HY_SB(); HY_MM(a[2], bx, 0); HY_SB(); HY_RD(bx, off[3], 0, CLAMP); HY_SB(); HY_MM(a[2], by, 1); HY_SB();
        HY_RD(by, off[3], 1, CLAMP); HY_SB(); HY_MM(a[3], bx, 0); HY_SB();
#pragma unroll
        for (int u = 0; u < 4; ++u) off[u] -= 8 * CB;
        if (CLAMP || (next_clamped && g + 1 == g1)) HY_RD(bx, off[0], 0, true); else HY_RD(bx, off[0], 0, false);
        HY_SB(); HY_MM(a[3], by, 1); HY_SB();
#pragma unroll
        for (int u = 0; u < 4; ++u) a[u] = an[u];
    }
#undef HY_RD
#undef HY_MM
#undef HY_SB
}
template <int NB, int L> __device__ __forceinline__ void hyena_unit(const Frame& F, int c) {
    constexpr bool SEG = (L == LS);
    constexpr int TPB = 32 / NB, NTILES = NB * (L / 32) / 32, TPW = NTILES / NWAVES, CH = L / 8, CB = NB * 16, ZB = 4096, ZIMG = NB * L * 2;
    constexpr int NSTEP = L / 16 + 2 * (TPW * TPB - 1), NG = (NSTEP + 3) / 4;
    static_assert(ZB + ZIMG + ZB <= RING_BYTES + 12288, "Z image + pads fit the LDS allocation");
    const size_t zbase = (SEG ? (size_t)TOKP * 512 : 0) + (size_t)c * L;
    const bf16* zT = (const bf16*)(F.ws + WS_ZT) + zbase; const bf16* x0T = (const bf16*)(F.ws + WS_X0T) + zbase; bf16* yT = (bf16*)(F.ws + WS_YT) + zbase;
    const bf16* T0 = (const bf16*)(F.ws + WS_TAB) + (SEG ? (size_t)512 * 2 * 2 * LP : 0) + (size_t)c * 4 * L; const bf16* T1 = T0 + 2 * L;
    LAS unsigned char* lds = F.lds;
    __syncthreads();
    for (int q = F.tid; q < 2 * ZB / 16; q += NWAVES * 64) *(LAS v4u*)(lds + (q < ZB / 16 ? q * 16 : ZIMG + q * 16)) = (v4u){0u, 0u, 0u, 0u};
    { v4u wsum = (v4u){0u, 0u, 0u, 0u};
#pragma unroll
      for (int i = 0; i < (8 * L) / (16 * NWAVES * 64); ++i) { const v4u v = *(const GAS v4u*)((const char*)T0 + (size_t)(i * NWAVES * 64 + F.tid) * 16); wsum.x |= v.x; wsum.y |= v.y; wsum.z |= v.z; wsum.w |= v.w; }
      asm volatile("" :: "v"(wsum)); }
    for (int q = F.tid; q < NB * CH; q += NWAVES * 64) { const int b = q / CH, tc = q % CH; const v4u v = *(const GAS v4u*)(zT + (size_t)b * 512 * L + tc * 8); *(LAS v4u*)(lds + ZB + zaddr<NB>(tc, b)) = v; }
    __syncthreads();
    const int lane = F.lane, n = lane & 31, kg = lane >> 5, bn = n % NB, t1o = n / NB;
    const int t1_lo = F.wave * TPW * TPB, e_max = 2 * (t1_lo + TPW * TPB - 1), e0 = e_max - 4 * NG + 1;
    const int tcg0 = 4 * (t1_lo + t1o) - 2 * e0 + kg;
    int off[4];
#pragma unroll
    for (int u = 0; u < 4; ++u) off[u] = ZB + zaddr<NB>(tcg0 - 2 * u, bn);
    const char* pa = (const char*)(((n & 1) ? T1 - 1 : T0) + (L - n + 8 * kg)) - 32 * (long)e0;
    f32x16 acc[TPW];
#pragma unroll
    for (int jj = 0; jj < TPW; ++jj) acc[jj] = f32x16{};
    v4u a[4];
#pragma unroll
    for (int u = 0; u < 4; ++u) a[u] = *(const GAS v4u_a4*)(pa - 32 * u);
    pa -= 128;
    constexpr int ZTOP = ZB + ZIMG + ZB - 16, HT = TPW / 2;
    const int t1_hi = t1_lo + TPW * TPB - 1;
    int gA = (2 * t1_hi + 1 - (CH - 1) / 2 - e0 + 3) >> 2; gA = gA < 0 ? 0 : gA;
    int gB = ((2 * t1_lo - 3 - e0) >> 2) + 1; gB = gB > NG ? NG : gB; if (gB < gA) gB = gA;
    v4u bx[HT], by[HT];
    { int ad0[HT];
#pragma unroll
      for (int jj = 0; jj < HT; ++jj) { int ad = off[0] + jj * 2048; ad0[jj] = ad < 0 ? 0 : (ad > ZTOP ? ZTOP : ad); bx[jj] = *(const LAS v4u*)(lds + ad0[jj]); } }
    hy_groups<TPW, CB, ZTOP, true>(0, gA, lds, acc, a, bx, by, off, pa, false);
    hy_groups<TPW, CB, ZTOP, false>(gA, gB, lds, acc, a, bx, by, off, pa, true);
    hy_groups<TPW, CB, ZTOP, true>(gB, NG, lds, acc, a, bx, by, off, pa, false);
    const float dc = F.in[13][c];
    int n2 = n, kg2 = kg; asm volatile("" : "+v"(n2), "+v"(kg2));
    const int bn2 = n2 % NB, t1o2 = n2 / NB;
#pragma unroll
    for (int jj = 0; jj < TPW; ++jj) {
        const int t1 = t1_lo + jj * TPB + t1o2;
        const size_t gb = (size_t)bn2 * 512 * L + 32 * t1 + 4 * kg2;
#pragma unroll
        for (int rq = 0; rq < 4; ++rq) {
            const v2u zz = *(const LAS v2u*)(lds + ZB + zaddr<NB>(4 * t1 + rq, bn2) + 8 * kg2);
            const v2u xx = *(const GAS v2u*)(x0T + gb + 8 * rq);
            const float y0 = (acc[jj][4 * rq + 0] + dc * bflo(zz.x)) * bflo(xx.x), y1 = (acc[jj][4 * rq + 1] + dc * bfhi(zz.x)) * bfhi(xx.x);
            const float y2 = (acc[jj][4 * rq + 2] + dc * bflo(zz.y)) * bflo(xx.y), y3 = (acc[jj][4 * rq + 3] + dc * bfhi(zz.y)) * bfhi(xx.y);
            *(GAS v2u*)(yT + gb + 8 * rq) = (v2u){pk2(y0, y1), pk2(y2, y3)};
        }
    }
}
typedef float f32x4_a4 __attribute__((ext_vector_type(4), aligned(4)));
template <int L> __device__ __forceinline__ void hyena_build_table(const Frame& F, int c, int tid, bf16* T0, LAS float* red) {
    constexpr bool SEG = (L == LS);
    const float* hf = (const float*)(F.ws + WS_HRAW) + (SEG ? (size_t)1024 * LP : 0) + (size_t)c * L; const float* hbk = hf + (size_t)512 * L;
    float s = 0.f;
#pragma unroll
    for (int i = 0; i < L / 2048; ++i) { const int t = (tid + i * 512) * 4; const f32x4 a = *(const GAS f32x4*)(hf + t), b = *(const GAS f32x4*)(hbk + t);
        s += (fabsf(a.x) + fabsf(a.y)) + (fabsf(a.z) + fabsf(a.w)) + (t == 0 ? 0.f : fabsf(b.x)) + fabsf(b.y) + (fabsf(b.z) + fabsf(b.w)); }
    s = wave_sum(s);
    if ((tid & 63) == 0) red[tid >> 6] = s;
    __syncthreads();
    float tot = 0.f;
#pragma unroll
    for (int w = 0; w < NWAVES; ++w) tot += red[w];
    const float inv = 1.0f / tot;
    bf16* T1 = T0 + 2 * L;
#pragma unroll
    for (int i = 0; i < L / 2048; ++i) {
        const int x0 = (tid + i * 512) * 8;
        float v[9];
        if (x0 < L) {
            const f32x4 p = *(const GAS f32x4_a4*)(hf + L - x0 - 8), q = *(const GAS f32x4_a4*)(hf + L - x0 - 4); const float r0 = (x0 == 0) ? 0.f : hf[L - x0];
            v[0] = r0; v[1] = q.w; v[2] = q.z; v[3] = q.y; v[4] = q.x; v[5] = p.w; v[6] = p.z; v[7] = p.y; v[8] = p.x;
        } else {
            const int m = x0 - L; const f32x4 p = *(const GAS f32x4*)(hbk + m), q = *(const GAS f32x4*)(hbk + m + 4); const float r8 = (m + 8 >= L) ? 0.f : hbk[m + 8];
            v[0] = (m == 0) ? hf[0] : p.x; v[1] = p.y; v[2] = p.z; v[3] = p.w; v[4] = q.x; v[5] = q.y; v[6] = q.z; v[7] = q.w; v[8] = r8;
        }
#pragma unroll
        for (int j = 0; j < 9; ++j) v[j] *= inv;
        *(GAS v4u*)(T0 + x0) = (v4u){pk2(v[0], v[1]), pk2(v[2], v[3]), pk2(v[4], v[5]), pk2(v[6], v[7])};
        *(GAS v4u*)(T1 + x0) = (v4u){pk2(v[1], v[2]), pk2(v[3], v[4]), pk2(v[5], v[6]), pk2(v[7], v[8])};
    }
}
template <int TPW, int CB, int ZTOP, bool CLAMP, int JLO = 0, int JHI = TPW / 2>
__device__ __forceinline__ void hy2_groups(int g0, int g1, LAS unsigned char* lds, f32x16 (&acc)[TPW], v4u (&a)[6], v4u (&bx)[TPW / 2], v4u (&by)[TPW / 2], int (&off)[4], const char*& pa, bool next_clamped) {
    constexpr int NC = TPW / 2;
#define HY_RD(dst, base, CL) do { _Pragma("unroll") for (int jc = JLO; jc < JHI; ++jc) { int ad = (base) + jc * 4096; if (CL) ad = ad < 0 ? 0 : (ad > ZTOP ? ZTOP : ad); dst[jc] = *(const LAS v4u*)(lds + ad); } } while (0)
#define HY_MM(a0, a1, src) do { _Pragma("unroll") for (int jc = JLO; jc < JHI; ++jc) { \
        acc[2 * jc] = __builtin_amdgcn_mfma_f32_32x32x16_bf16(__builtin_bit_cast(s16x8, a0), __builtin_bit_cast(s16x8, src[jc]), acc[2 * jc], 0, 0, 0); \
        acc[2 * jc + 1] = __builtin_amdgcn_mfma_f32_32x32x16_bf16(__builtin_bit_cast(s16x8, a1), __builtin_bit_cast(s16x8, src[jc]), acc[2 * jc + 1], 0, 0, 0); } } while (0)
#define HY_SB() __builtin_amdgcn_sched_barrier(0)
#define HY_RDALL(dst, base, CL) do { _Pragma("unroll") for (int jc = 0; jc < NC; ++jc) { int ad = (base) + jc * 4096; if (CL) ad = ad < 0 ? 0 : (ad > ZTOP ? ZTOP : ad); dst[jc] = *(const LAS v4u*)(lds + ad); } } while (0)
    for (int g = g0; g < g1; ++g) {
        v4u an[4];
#pragma unroll
        for (int q = 0; q < 4; ++q) an[q] = *(const GAS v4u_a4*)(pa - 32 * q);
        pa -= 128;
        HY_SB();
        HY_RD(by, off[1], CLAMP); HY_SB(); HY_MM(a[0], a[2], bx); HY_SB();
        HY_RD(bx, off[2], CLAMP); HY_SB(); HY_MM(a[1], a[3], by); HY_SB();
        HY_RD(by, off[3], CLAMP); HY_SB(); HY_MM(a[2], a[4], bx); HY_SB();
#pragma unroll
        for (int v = 0; v < 4; ++v) off[v] -= 8 * CB;
        if (CLAMP || (next_clamped && g + 1 == g1)) HY_RDALL(bx, off[0], true); else HY_RDALL(bx, off[0], false);
        HY_SB(); HY_MM(a[3], a[5], by); HY_SB();
        a[0] = a[4]; a[1] = a[5];
#pragma unroll
        for (int q = 0; q < 4; ++q) a[2 + q] = an[q];
    }
#undef HY_RD
#undef HY_MM
#undef HY_SB
#undef HY_RDALL
}
template <int NB, int L> __device__ __forceinline__ void hyena2_unit(const Frame& F, int c) {
    constexpr bool SEG = (L == LS);
    constexpr int TPB = 32 / NB, NTILES = NB * (L / 32) / 32, TPW = NTILES / NWAVES, NC = TPW / 2, CH = L / 8, CB = NB * 16, ZB = 4096, ZIMG = NB * L * 2;
    constexpr int USPAN = NC * TPB;
    constexpr int NSTEP = L / 16 + 4 * (USPAN - 1), NG = NSTEP / 4;
    static_assert(NSTEP % 4 == 0 && ZB + ZIMG + ZB <= LDS_BYTES - 64, "hyena2 geometry");
    const size_t zbase = (SEG ? (size_t)TOKP * 512 : 0) + (size_t)c * L;
    const bf16* zT = (const bf16*)(F.ws + WS_ZT) + zbase; const bf16* x0T = (const bf16*)(F.ws + WS_X0T) + zbase; bf16* yT = (bf16*)(F.ws + WS_YT) + zbase;
    const bf16* T0 = (const bf16*)(F.ws + WS_TAB) + (SEG ? (size_t)512 * 2 * 2 * LP : 0) + (size_t)c * 4 * L; const bf16* T1 = T0 + 2 * L;
    LAS unsigned char* lds = F.lds;
    int tid = F.tid; asm volatile("" : "+v"(tid));
    __syncthreads();
    hyena_build_table<L>(F, c, tid, (bf16*)T0, (LAS float*)(lds + LDS_BYTES - 256));
    for (int q = tid; q < 2 * ZB / 16; q += NWAVES * 64) *(LAS v4u*)(lds + (q < ZB / 16 ? q * 16 : ZIMG + q * 16)) = (v4u){0u, 0u, 0u, 0u};
    { constexpr int NIT = NB * CH / (NWAVES * 64);
#pragma unroll
      for (int i0 = 0; i0 < NIT; i0 += 8) { v4u v[8];
#pragma unroll
        for (int i = 0; i < 8; ++i) { const int q = tid + (i0 + i) * NWAVES * 64, b = q / CH, tc = q % CH; v[i] = *(const GAS v4u*)(zT + (size_t)b * 512 * L + tc * 8); }
#pragma unroll
        for (int i = 0; i < 8; ++i) { const int q = tid + (i0 + i) * NWAVES * 64, b = q / CH, tc = q % CH; *(LAS v4u*)(lds + ZB + zaddr<NB>(tc, b)) = v[i]; } } }
    asm volatile("s_waitcnt vmcnt(0)" ::: "memory");
    __syncthreads();
    const int lane = tid & 63, n = lane & 31, kg = lane >> 5, bn = n % NB, uo = n / NB;
    const int u_lo = F.wave * USPAN, u_hi = u_lo + USPAN - 1, e0 = 4 * u_lo - L / 16 + 1;
    const int tcg0 = 8 * (u_lo + uo) - 2 * e0 + kg;
    int off[4];
#pragma unroll
    for (int v = 0; v < 4; ++v) off[v] = ZB + zaddr<NB>(tcg0 - 2 * v, bn);
    const char* pa = (const char*)(((n & 1) ? T1 - 1 : T0) + (L - n + 8 * kg)) - 32 * (long)e0;
    f32x16 acc[TPW];
#pragma unroll
    for (int jj = 0; jj < TPW; ++jj) acc[jj] = f32x16{};
    v4u a[6];
#pragma unroll
    for (int q = 0; q < 6; ++q) a[q] = *(const GAS v4u_a4*)(pa - 32 * q);
    pa -= 192;
    constexpr int ZTOP = ZB + ZIMG + ZB - 16;
    int gA = (4 * u_hi + 1 - (CH - 1) / 2 - e0 + 3) >> 2; gA = gA < 0 ? 0 : gA;
    int gB = ((4 * u_lo - 3 - e0) >> 2) + 1; gB = gB > NG ? NG : gB; if (gB < gA) gB = gA;
    v4u bx[NC], by[NC];
#pragma unroll
    for (int jc = 0; jc < NC; ++jc) { int ad = off[0] + jc * 4096; ad = ad < 0 ? 0 : (ad > ZTOP ? ZTOP : ad); bx[jc] = *(const LAS v4u*)(lds + ad); }
    constexpr int G_ALL0 = TPB * (NC - 1), G_ALL1 = L / 64 + TPB - 1;
    static_assert(G_ALL1 + (NC - 1) * TPB == NG && (NC == 4 || NC == 2), "segment map");
    gA = gA < G_ALL0 ? G_ALL0 : gA; gB = gB > G_ALL1 ? G_ALL1 : gB; if (gB < gA) gB = gA;
    if constexpr (NC == 4) {
        hy2_groups<TPW, CB, ZTOP, true, 0, 1>(0, TPB, lds, acc, a, bx, by, off, pa, false);
        hy2_groups<TPW, CB, ZTOP, true, 0, 2>(TPB, 2 * TPB, lds, acc, a, bx, by, off, pa, false);
        hy2_groups<TPW, CB, ZTOP, true, 0, 3>(2 * TPB, 3 * TPB, lds, acc, a, bx, by, off, pa, false);
    } else {
        hy2_groups<TPW, CB, ZTOP, true, 0, 1>(0, TPB, lds, acc, a, bx, by, off, pa, false);
    }
    hy2_groups<TPW, CB, ZTOP, true>(G_ALL0, gA, lds, acc, a, bx, by, off, pa, false);
    hy2_groups<TPW, CB, ZTOP, false>(gA, gB, lds, acc, a, bx, by, off, pa, true);
    hy2_groups<TPW, CB, ZTOP, true>(gB, G_ALL1, lds, acc, a, bx, by, off, pa, false);
    if constexpr (NC == 4) {
        hy2_groups<TPW, CB, ZTOP, true, 1, 4>(G_ALL1, G_ALL1 + TPB, lds, acc, a, bx, by, off, pa, false);
        hy2_groups<TPW, CB, ZTOP, true, 2, 4>(G_ALL1 + TPB, G_ALL1 + 2 * TPB, lds, acc, a, bx, by, off, pa, false);
        hy2_groups<TPW, CB, ZTOP, true, 3, 4>(G_ALL1 + 2 * TPB, NG, lds, acc, a, bx, by, off, pa, false);
    } else {
        hy2_groups<TPW, CB, ZTOP, true, 1, 2>(G_ALL1, NG, lds, acc, a, bx, by, off, pa, false);
    }
    const float dc = F.in[13][c];
    int n2 = n, kg2 = kg; asm volatile("" : "+v"(n2), "+v"(kg2));
    const int bn2 = n2 % NB, uo2 = n2 / NB;
#pragma unroll
    for (int jj = 0; jj < TPW; ++jj) {
        const int t1 = 2 * (u_lo + (jj >> 1) * TPB + uo2) + (jj & 1); const size_t gb = (size_t)bn2 * 512 * L + 32 * t1 + 8 * kg2;
        v4u X[2];
#pragma unroll
        for (int pr = 0; pr < 2; ++pr) X[pr] = *(const GAS v4u*)(x0T + gb + 16 * pr);
#pragma unroll
        for (int pr = 0; pr < 2; ++pr) {
            const unsigned s0 = kg2 ? X[pr].x : X[pr].z, s1 = kg2 ? X[pr].y : X[pr].w;
            const auto r0 = __builtin_amdgcn_permlane32_swap(s0, s0, false, false); const auto r1 = __builtin_amdgcn_permlane32_swap(s1, s1, false, false);
            const unsigned rc0 = kg2 ? r0[0] : r0[1], rc1 = kg2 ? r1[0] : r1[1];
            v2u xq[2];
            xq[0] = kg2 ? (v2u){rc0, rc1} : (v2u){X[pr].x, X[pr].y};
            xq[1] = kg2 ? (v2u){X[pr].z, X[pr].w} : (v2u){rc0, rc1};
            v2u wq[2];
#pragma unroll
            for (int e = 0; e < 2; ++e) { const int rq = 2 * pr + e;
                const v2u zz = *(const LAS v2u*)(lds + ZB + zaddr<NB>(4 * t1 + rq, bn2) + 8 * kg2);
                const float y0 = (acc[jj][4 * rq + 0] + dc * bflo(zz.x)) * bflo(xq[e].x), y1 = (acc[jj][4 * rq + 1] + dc * bfhi(zz.x)) * bfhi(xq[e].x);
                const float y2 = (acc[jj][4 * rq + 2] + dc * bflo(zz.y)) * bflo(xq[e].y), y3 = (acc[jj][4 * rq + 3] + dc * bfhi(zz.y)) * bfhi(xq[e].y);
                wq[e] = (v2u){pk2(y0, y1), pk2(y2, y3)}; }
            const unsigned t0 = kg2 ? wq[0].x : wq[1].x, t1s = kg2 ? wq[0].y : wq[1].y;
            const auto q0 = __builtin_amdgcn_permlane32_swap(t0, t0, false, false); const auto q1 = __builtin_amdgcn_permlane32_swap(t1s, t1s, false, false);
            const unsigned g0 = kg2 ? q0[0] : q0[1], g1 = kg2 ? q1[0] : q1[1];
            const v4u outp = kg2 ? (v4u){g0, g1, wq[1].x, wq[1].y} : (v4u){wq[0].x, wq[0].y, g0, g1};
            *(GAS v4u*)(yT + gb + 16 * pr) = outp;
        }
    }
}
__device__ __forceinline__ void p3_attn(const Frame& F, char* lds_generic) {
    using abf = attn_body::bf16;
    const abf* Q = (const abf*)(F.ws + WS_Q); const abf* K = (const abf*)(F.ws + WS_K); const abf* V = (const abf*)(F.ws + WS_V); abf* O = (abf*)(F.ws + WS_O);
    const int NCU = F.G;
    float gqm = fabsf(F.in[14][F.lane]), gkm = fabsf(F.in[15][F.lane]);
#pragma unroll
    for (int o = 1; o < 64; o <<= 1) { gqm = fmaxf(gqm, __shfl_xor(gqm, o)); gkm = fmaxf(gkm, __shfl_xor(gkm, o)); }
    const float mref = 64.0f * QSCALE * gqm * gkm * 1.02f;
    if (NCU == 256) {
        const int x = F.vcu >> 5, j = F.vcu & 31;
        for (int i = 0; i < 8; ++i) { const int p = 2 * x + (i >> 2), hh = i & 3, b = p >> 1, kvh = p & 1;
            attn_body::attn_unit<8>((long)TOKP + (long)b * LS + (long)j * 256, (long)TOKP + (long)b * LS, LS, kvh * 4 + hh, Q, K, V, O, lds_generic, (long)TT, mref); }
        for (int i = 0; i < 4; ++i) { const int p = 4 * x + i, hh = j >> 3, qb = j & 7, b = p >> 1, kvh = p & 1;
            attn_body::attn_unit<8>((long)b * LP + (long)qb * 256, (long)b * LP, LP, kvh * 4 + hh, Q, K, V, O, lds_generic, (long)TT, mref); }
    } else {
        for (int u = F.vcu; u < 2048; u += NCU) { const int p = u >> 7, hh = (u >> 5) & 3, qb = u & 31, b = p >> 1, kvh = p & 1;
            attn_body::attn_unit<8>((long)TOKP + (long)b * LS + (long)qb * 256, (long)TOKP + (long)b * LS, LS, kvh * 4 + hh, Q, K, V, O, lds_generic, (long)TT, mref); }
        for (int u = F.vcu; u < 1024; u += NCU) { const int p = u >> 5, hh = (u >> 3) & 3, qb = u & 7, b = p >> 1, kvh = p & 1;
            attn_body::attn_unit<8>((long)b * LP + (long)qb * 256, (long)b * LP, LP, kvh * 4 + hh, Q, K, V, O, lds_generic, (long)TT, mref); }
    }
    asm volatile("s_waitcnt vmcnt(0) lgkmcnt(0)" ::: "memory");
}
__device__ __forceinline__ void p3_hyena(const Frame& F) {
    const int NCU = F.G;
    for (int c = F.vcu; c < HYW; c += NCU) hyena2_unit<NBS, LS>(F, c);
    for (int c = F.vcu; c < HYW; c += NCU) hyena2_unit<NBP, LP>(F, c);
}
__device__ __forceinline__ void p4_task(const Frame& F, int tt) {
    const bf16* yT = (const bf16*)(F.ws + WS_YT); const bf16* o = (const bf16*)(F.ws + WS_O); bf16* mixed = (bf16*)(F.ws + WS_MIX);
    const int m0 = tt * 64; int s0, L; seq_of(m0, s0, L);
    const int tl0 = m0 - s0; LAS unsigned char* lds = F.lds; constexpr int RS = 1040;
    __syncthreads();
    { const int chunk = F.tid & 7, cs = F.tid >> 3;
#pragma unroll
      for (int ps = 0; ps < 8; ++ps) { const int c = ps * 64 + cs; const v4u v = *(const GAS v4u*)(yT + (size_t)s0 * 512 + (size_t)c * L + tl0 + 8 * chunk);
        LAS unsigned short* d = (LAS unsigned short*)(lds + (8 * chunk) * RS + 2 * c);
        d[0 * (RS / 2)] = (unsigned short)v.x; d[1 * (RS / 2)] = (unsigned short)(v.x >> 16); d[2 * (RS / 2)] = (unsigned short)v.y; d[3 * (RS / 2)] = (unsigned short)(v.y >> 16);
        d[4 * (RS / 2)] = (unsigned short)v.z; d[5 * (RS / 2)] = (unsigned short)(v.z >> 16); d[6 * (RS / 2)] = (unsigned short)v.w; d[7 * (RS / 2)] = (unsigned short)(v.w >> 16); } }
    __syncthreads();
    const int lane = F.lane;
    const f32x4 gh0 = *(const GAS f32x4*)(F.in[16] + 8 * lane), gh1 = *(const GAS f32x4*)(F.in[16] + 8 * lane + 4), ga0 = *(const GAS f32x4*)(F.in[17] + 8 * lane), ga1 = *(const GAS f32x4*)(F.in[17] + 8 * lane + 4);
#pragma unroll
    for (int i = 0; i < 8; ++i) {
        const int t = F.wave * 8 + i; const size_t m = (size_t)m0 + t;
#pragma unroll
        for (int part = 0; part < 2; ++part) {
            const v4u v = part == 0 ? *(const LAS v4u*)(lds + t * RS + 16 * lane) : *(const GAS v4u*)(o + m * QW + 8 * lane);
            float f[8] = {bflo(v.x), bfhi(v.x), bflo(v.y), bfhi(v.y), bflo(v.z), bfhi(v.z), bflo(v.w), bfhi(v.w)};
            float s = 0.f;
#pragma unroll
            for (int q = 0; q < 8; ++q) s += f[q] * f[q];
            const float rstd = 1.0f / sqrtf(wave_sum(s) * (1.0f / 512.0f) + EPS);
            const f32x4 g0 = part == 0 ? gh0 : ga0, g1 = part == 0 ? gh1 : ga1;
            const v4u w = (v4u){pk2(f[0] * rstd * g0.x, f[1] * rstd * g0.y), pk2(f[2] * rstd * g0.z, f[3] * rstd * g0.w), pk2(f[4] * rstd * g1.x, f[5] * rstd * g1.y), pk2(f[6] * rstd * g1.z, f[7] * rstd * g1.w)};
            *(GAS v4u*)(mixed + m * DM + part * 512 + 8 * lane) = w;
        }
    }
}
__device__ __forceinline__ void p9_rows4(const Frame& F, int m) {
    const bf16* yb = (const bf16*)(F.ws + WS_B); const float* rsq = (const float*)(F.ws + WS_ROWSQ2);
    v4u v[4][2]; float rstd[4];
#pragma unroll
    for (int i = 0; i < 4; ++i) { rstd[i] = rsq[m + i];
#pragma unroll
        for (int j = 0; j < 2; ++j) v[i][j] = *(const GAS v4u*)(yb + (size_t)(m + i) * DM + 512 * j + 8 * F.lane); }
    f32x4 g[2][2];
#pragma unroll
    for (int j = 0; j < 2; ++j) { g[j][0] = *(const GAS f32x4*)(F.in[23] + 512 * j + 8 * F.lane); g[j][1] = *(const GAS f32x4*)(F.in[23] + 512 * j + 8 * F.lane + 4); }
#pragma unroll
    for (int i = 0; i < 4; ++i) { const float rs = 1.0f / sqrtf(rstd[i] * (1.0f / DM) + EPS);
#pragma unroll
        for (int j = 0; j < 2; ++j) { const v4u w = v[i][j]; float* o = F.out + (size_t)(m + i) * DM + 512 * j + 8 * F.lane;
            *(GAS f32x4*)o = (f32x4){bflo(w.x) * rs * g[j][0].x, bfhi(w.x) * rs * g[j][0].y, bflo(w.y) * rs * g[j][0].z, bfhi(w.y) * rs * g[j][0].w};
            *(GAS f32x4*)(o + 4) = (f32x4){bflo(w.z) * rs * g[j][1].x, bfhi(w.z) * rs * g[j][1].y, bflo(w.w) * rs * g[j][1].z, bfhi(w.w) * rs * g[j][1].w}; } }
}
#ifndef MK_N_LAUNCHES
#define MK_N_LAUNCHES 1
#endif
constexpr int N_PHASES = 10;

struct Args { const float* in[24]; float* out; unsigned char* ws; int ph_lo, ph_hi, li, pad; };
__global__ void __launch_bounds__(NWAVES * 64, 2) hymba_fwd(Args args) {
    extern __shared__ __attribute__((aligned(16))) unsigned char lds_raw[];
    cg::grid_group grid = cg::this_grid();
    Frame F;
    F.lds = (LAS unsigned char*)lds_raw;
    F.tid = threadIdx.x; F.lane = F.tid & 63; F.wave = __builtin_amdgcn_readfirstlane(F.tid >> 6);
    F.G = gridDim.x; { const int bx = blockIdx.x; F.vcu = (F.G % 8 == 0) ? (bx % 8) * (F.G / 8) + bx / 8 : bx; }
    F.in = (const __attribute__((address_space(4))) cfp*)__builtin_amdgcn_kernarg_segment_ptr();
    F.out = args.out; F.ws = args.ws;
    if (F.tid < 16) ((LAS unsigned*)(F.lds + BARST_OFF))[F.tid] = 0u;
    __syncthreads();
    XcdBarrier bar = xcd_barrier_post((unsigned*)(F.ws + WS_BAR) + args.li * XCD_BAR_WORDS, (volatile LAS unsigned*)(F.lds + BARST_OFF));
    const int lo = args.ph_lo, hi = args.ph_hi;
#define IN(k) (lo <= (k) && (k) < hi)
#define SEAM(k) do { if (IN(k) && IN((k) + 1)) { if ((k) == 0) grid.sync(); else xcd_barrier(bar); } } while (0)

    if (IN(0)) { p0_prologue(F); } SEAM(0);
    if (IN(1)) {
        pg8::Gemm g{(const pg8::bf16_t*)(F.ws + WS_B), (const pg8::bf16_t*)(F.ws + WS_WIN), TT, INC, DM}; pg8::StaticOrder S; S.init(TT, INC, F.G, (int)blockIdx.x);
        pg8::EpiBf16<0> E{(pg8::bf16_t*)(F.ws + WS_A), INC, nullptr, 0, 0, 1.f};
        pg8::gemm_phase<pg8::EpiBf16<0>, pg8::StaticOrder, PG8_ALIGN, PG8_SP2>(F.lds, g, S, E);
    } SEAM(1);
    if (IN(2)) { p2_phase(F); } SEAM(2);
    if (IN(3)) { p3_attn(F, (char*)lds_raw); }
    if (IN(4)) { p3_hyena(F); } SEAM(4);
    if (IN(5)) { for (int tt = F.vcu; tt < TT / 64; tt += F.G) p4_task(F, tt); } SEAM(5);
    if (IN(6)) {
        pg8::Gemm g{(const pg8::bf16_t*)(F.ws + WS_MIX), (const pg8::bf16_t*)(F.ws + WS_WOUT), TT, DM, DM}; pg8::StaticOrder S; S.init(TT, DM, F.G, (int)blockIdx.x);
        pg8::EpiX1 E{F.in[0], F.in[1], (pg8::bf16_t*)(F.ws + WS_B), (float*)(F.ws + WS_ROWSQ1)};
        pg8::gemm_phase<pg8::EpiX1, pg8::StaticOrder, PG8_ALIGN, PG8_SP2>(F.lds, g, S, E);
    } SEAM(6);
    if (IN(7)) {
        pg8::Gemm g{(const pg8::bf16_t*)(F.ws + WS_B), (const pg8::bf16_t*)(F.ws + WS_WGU), TT, 2 * DFF, DM}; pg8::StaticOrder S; S.init(TT, 2 * DFF, F.G, (int)blockIdx.x);
        pg8::EpiSwiGLU E{(pg8::bf16_t*)(F.ws + WS_A), (const float*)(F.ws + WS_ROWSQ1), DFF, EPS};
        pg8::gemm_phase<pg8::EpiSwiGLU, pg8::StaticOrder, PG8_ALIGN, PG8_SP2>(F.lds, g, S, E);
    } SEAM(7);
    if (IN(8)) {
        pg8::Gemm g{(const pg8::bf16_t*)(F.ws + WS_A), (const pg8::bf16_t*)(F.ws + WS_WD), TT, DM, DFF}; pg8::StaticOrder S; S.init(TT, DM, F.G, (int)blockIdx.x); S.rev = 1;
        pg8::EpiY E{(pg8::bf16_t*)(F.ws + WS_B), (float*)(F.ws + WS_ROWSQ2)};
        pg8::gemm_phase<pg8::EpiY, pg8::StaticOrder, PG8_ALIGN, PG8_SP2>(F.lds, g, S, E);
    } SEAM(8);
    if (IN(9)) { const int gw = F.vcu * NWAVES + F.wave, NGW = F.G * NWAVES; for (int m = gw * 4; m < TT; m += NGW * 4) p9_rows4(F, m); }
#undef IN
#undef SEAM
}

extern "C" void kernel_launch(void* const* d_in, const int* in_sizes, int n_in, void* d_out, int out_size, void* d_ws, size_t ws_size, hipStream_t stream) {
    static int grid = 0;
    if (grid == 0) {
        if (n_in != 24 || out_size != TT * DM || ws_size < WS_END) { fprintf(stderr, "kernel_launch: unexpected shapes (n_in %d out %d ws %zu)\n", n_in, out_size, ws_size); grid = -1; return; }
        int dev = 0, cus = 0, per_cu = 0;
        hipGetDevice(&dev); hipDeviceGetAttribute(&cus, hipDeviceAttributeMultiprocessorCount, dev);
        if (hipFuncSetAttribute((const void*)hymba_fwd, hipFuncAttributeMaxDynamicSharedMemorySize, LDS_BYTES) != hipSuccess) { fprintf(stderr, "kernel_launch: hipFuncSetAttribute failed\n"); grid = -1; return; }
        if (hipOccupancyMaxActiveBlocksPerMultiprocessor(&per_cu, (const void*)hymba_fwd, NWAVES * 64, LDS_BYTES) != hipSuccess || per_cu < 1) { fprintf(stderr, "kernel_launch: occupancy query says %d\n", per_cu); per_cu = 1; }
        (void)hipGetLastError();
        grid = cus;
        fprintf(stderr, "kernel_launch: grid %d (per_cu %d)\n", grid, per_cu);
    }
    if (grid < 0) return;
    hipMemsetAsync((char*)d_ws + WS_CTL, 0, CTL_ZERO_BYTES, stream);
    Args a{};
    for (int i = 0; i < 24; ++i) a.in[i] = (const float*)d_in[i];
    a.out = (float*)d_out; a.ws = (unsigned char*)d_ws;
#if defined(PROBE_LO)
    { const int cuts[4][2] = {{0, PROBE_HI}, {PROBE_LO, PROBE_HI}, {PROBE_HI, N_PHASES}, {0, 0}};
      for (int li = 0; li < 3; ++li) { if (cuts[li][0] >= cuts[li][1]) continue; a.ph_lo = cuts[li][0]; a.ph_hi = cuts[li][1]; a.li = li; void* kargs[] = {&a};
        hipError_t e = hipLaunchCooperativeKernel((const void*)hymba_fwd, dim3(grid), dim3(NWAVES * 64), kargs, LDS_BYTES, stream);
        if (e != hipSuccess) fprintf(stderr, "kernel_launch: launch %d failed: %s\n", li, hipGetErrorString(e)); } }
#elif MK_N_LAUNCHES == 1
    a.ph_lo = 0; a.ph_hi = N_PHASES;
    { void* kargs[] = {&a}; hipError_t e = hipLaunchCooperativeKernel((const void*)hymba_fwd, dim3(grid), dim3(NWAVES * 64), kargs, LDS_BYTES, stream);
      if (e != hipSuccess) fprintf(stderr, "kernel_launch: cooperative launch failed: %s\n", hipGetErrorString(e)); }
#else
    for (int p = 0; p < N_PHASES; ++p) { a.ph_lo = p; a.ph_hi = p + 1; a.li = 0; void* kargs[] = {&a};
      hipError_t e = hipLaunchCooperativeKernel((const void*)hymba_fwd, dim3(grid), dim3(NWAVES * 64), kargs, LDS_BYTES, stream);
      if (e != hipSuccess) fprintf(stderr, "kernel_launch: launch %d failed: %s\n", p, hipGetErrorString(e)); }
#endif
}
```
